# Optimizing an MI355X kernel written in HIP

```python
import math
import jax
import jax.numpy as jnp
from jax import lax
import numpy as np

D_MODEL = 1024
BATCH = 8
SEQ = 2048
DEPTH = 1

CTX_LEN = 256
GRID_W = 64

ATTN_HEADS = 8
ATTN_KV_HEADS = 2
ATTN_GROUP = ATTN_HEADS // ATTN_KV_HEADS
HEAD_DIM = 128
ROPE_AXIS_DIM = HEAD_DIM // 2
ROPE_THETA = 10000.0
Q_BLOCK = 128

GDN_HEADS = 8
GDN_DK = 128
GDN_DV = 128
GDN_CHUNK = 64
SHORT_CONV = 3

D_FF = 2816
FFN_CONV = 3

NORM_EPS = 1e-6

ATTN_Q_W = ATTN_HEADS * HEAD_DIM
ATTN_KV_W = ATTN_KV_HEADS * HEAD_DIM
GDN_QK_W = GDN_HEADS * GDN_DK
GDN_V_W = GDN_HEADS * GDN_DV
GDN_CONV_W = 2 * GDN_QK_W + GDN_V_W
IN_SPLITS = (ATTN_KV_W, ATTN_KV_W, GDN_CONV_W, 2 * GDN_HEADS, 2 * GDN_HEADS, ATTN_Q_W, GDN_V_W, 2 * D_MODEL)
CTX_COLS = 2 * ATTN_KV_W + GDN_CONV_W + 4 * GDN_HEADS
IN_COLS = CTX_COLS + ATTN_Q_W + GDN_V_W + 2 * D_MODEL

kernel_name = 'hybrid_gqa_gdn_convffn_prefix_block'


def rms_norm(x, gain=None):
    x32 = x.astype(jnp.float32)
    y = x32 * lax.rsqrt(jnp.mean(x32 * x32, axis=-1, keepdims=True) + NORM_EPS)
    if gain is not None:
        y = y * gain.astype(jnp.float32)
    return y.astype(x.dtype)


def l2_normalize(x):
    return x * lax.rsqrt(jnp.sum(x * x, axis=-1, keepdims=True) + NORM_EPS)


def modulate(h, shift, scale):
    return h * (1.0 + scale) + shift


def split_cols(p):
    parts, off = [], 0
    for size in IN_SPLITS:
        if off >= p.shape[-1]:
            break
        parts.append(p[..., off:off + size])
        off += size
    return parts


def dwconv_centred(x, w, b=None):
    width = w.shape[0]
    pad = width // 2
    n = x.shape[1]
    xp = jnp.pad(x, ((0, 0), (pad, pad), (0, 0)))
    y = xp[:, 0:n] * w[0]
    for j in range(1, width):
        y = y + xp[:, j:j + n] * w[j]
    return y if b is None else y + b


def axial_rope_tables(n):
    rows = n // GRID_W
    row_ids = jnp.broadcast_to(jnp.arange(rows, dtype=jnp.float32)[:, None], (rows, GRID_W)).reshape(n)
    col_ids = jnp.broadcast_to(jnp.arange(GRID_W, dtype=jnp.float32)[None, :], (rows, GRID_W)).reshape(n)
    inv_freq = ROPE_THETA ** (-jnp.arange(0, ROPE_AXIS_DIM, 2, dtype=jnp.float32) / ROPE_AXIS_DIM)
    ang = jnp.concatenate([row_ids[:, None] * inv_freq, col_ids[:, None] * inv_freq], axis=-1)
    ang = ang.reshape(n, 2, ROPE_AXIS_DIM // 2)
    return jnp.cos(ang), jnp.sin(ang)


def apply_axial_rope(x, cos, sin):
    x32 = x.astype(jnp.float32).reshape(*x.shape[:-1], 2, 2, ROPE_AXIS_DIM // 2)
    x1, x2 = x32[..., 0, :], x32[..., 1, :]
    cos = cos[None, :, None]
    sin = sin[None, :, None]
    out = jnp.stack([x1 * cos - x2 * sin, x2 * cos + x1 * sin], axis=-2)
    return out.reshape(x.shape).astype(x.dtype)


def sdpa_block(q, k, v):
    s = jnp.einsum('bqhgd,bkhd->bhgqk', q, k).astype(jnp.float32) * (HEAD_DIM ** -0.5)
    p = jax.nn.softmax(s, axis=-1).astype(v.dtype)
    return jnp.einsum('bhgqk,bkhd->bqhgd', p, v)


def latent_attention(q, k_all, v_all):
    b, n = q.shape[:2]
    nb = n // Q_BLOCK
    qb = jnp.moveaxis(q.reshape(b, nb, Q_BLOCK, *q.shape[2:]), 1, 0)
    o = lax.map(lambda q_blk: sdpa_block(q_blk, k_all, v_all), qb)
    return jnp.moveaxis(o, 0, 1).reshape(b, n, ATTN_Q_W)


def gdn_chunked(q, k, v, log_a, beta, s0, with_output):
    b, h, n, dk = q.shape
    dv = v.shape[-1]
    nc = n // GDN_CHUNK
    q = q.reshape(b, h, nc, GDN_CHUNK, dk)
    k = k.reshape(b, h, nc, GDN_CHUNK, dk)
    v = v.reshape(b, h, nc, GDN_CHUNK, dv)
    log_a = log_a.reshape(b, h, nc, GDN_CHUNK)
    beta = beta.reshape(b, h, nc, GDN_CHUNK)
    gam = jnp.cumsum(log_a, axis=-1)
    idx = jnp.arange(GDN_CHUNK)
    strict = idx[:, None] > idx[None, :]
    incl = idx[:, None] >= idx[None, :]
    dec = jnp.exp(jnp.where(incl, gam[..., :, None] - gam[..., None, :], -jnp.inf))
    kk = jnp.einsum('bhncd,bhnsd->bhncs', k, k)
    a_mat = jnp.where(strict, beta[..., :, None] * dec * kk, 0.0) + jnp.eye(GDN_CHUNK, dtype=jnp.float32)
    rhs = jnp.concatenate([beta[..., None] * v, (beta * jnp.exp(gam))[..., None] * k], axis=-1)
    uw = lax.linalg.triangular_solve(a_mat, rhs, left_side=True, lower=True, unit_diagonal=True)
    u, w = uw[..., :dv], uw[..., dv:]
    k_dec = k * jnp.exp(gam[..., -1:] - gam)[..., None]
    g_last = jnp.exp(gam[..., -1])
    xs = [u, w, k_dec, g_last]
    if with_output:
        q_dec = q * jnp.exp(gam)[..., None]
        p = dec * jnp.einsum('bhncd,bhnsd->bhncs', q, k)
        xs = xs + [q_dec, p]
    xs = tuple(jnp.moveaxis(t, 2, 0) for t in xs)

    def step(s, inp):
        u_c, w_c, kd_c, gl_c = inp[:4]
        delta = u_c - jnp.einsum('bhcd,bhde->bhce', w_c, s)
        s_new = gl_c[..., None, None] * s + jnp.einsum('bhcd,bhce->bhde', kd_c, delta)
        if with_output:
            qd_c, p_c = inp[4], inp[5]
            o = jnp.einsum('bhcd,bhde->bhce', qd_c, s) + jnp.einsum('bhcs,bhse->bhce', p_c, delta)
            return s_new, o
        return s_new, None

    s_fin, o = lax.scan(step, s0, xs)
    if with_output:
        o = jnp.moveaxis(o, 0, 2).reshape(b, h, n, dv)
    return o, s_fin


def gdn_prepare(qkv, db, da, conv_w, a_log, dt_bias):
    b, n, _ = qkv.shape
    qkv = jax.nn.silu(dwconv_centred(qkv, conv_w)).astype(jnp.float32)
    q, k, v = jnp.split(qkv, [GDN_QK_W, 2 * GDN_QK_W], axis=-1)
    q = l2_normalize(q.reshape(b, n, GDN_HEADS, GDN_DK)) * (GDN_DK ** -0.5)
    k = l2_normalize(k.reshape(b, n, GDN_HEADS, GDN_DK))
    v = v.reshape(b, n, GDN_HEADS, GDN_DV)
    q, k, v = (t.transpose(0, 2, 1, 3) for t in (q, k, v))
    beta = jax.nn.sigmoid(db.astype(jnp.float32)).reshape(b, n, 2, GDN_HEADS).transpose(2, 0, 3, 1)
    da = da.astype(jnp.float32).reshape(b, n, 2, GDN_HEADS).transpose(2, 0, 3, 1)
    log_a = -jnp.exp(a_log.astype(jnp.float32))[:, None, :, None] * jax.nn.softplus(
        da + dt_bias.astype(jnp.float32)[:, None, :, None])
    return q, k, v, log_a, beta


def gdn_bidirectional(ctx_in, lat_in, with_ctx_output):
    qc, kc, vc, lac, bc = ctx_in
    ql, kl, vl, lal, bl = lat_in
    s0 = jnp.zeros((ql.shape[0], GDN_HEADS, GDN_DK, GDN_DV), jnp.float32)
    o_lat, o_ctx = None, None
    for d in range(2):
        rev = (lambda t: jnp.flip(t, axis=2)) if d == 1 else (lambda t: t)
        oc, sc = gdn_chunked(rev(qc), rev(kc), rev(vc), rev(lac[d]), rev(bc[d]), s0, with_ctx_output)
        ol, _ = gdn_chunked(rev(ql), rev(kl), rev(vl), rev(lal[d]), rev(bl[d]), sc, True)
        o_lat = rev(ol) if o_lat is None else o_lat + rev(ol)
        if with_ctx_output:
            o_ctx = rev(oc) if o_ctx is None else o_ctx + rev(oc)
    return o_lat, o_ctx


def gdn_output(o, z, norm_w):
    b, n = z.shape[:2]
    o = rms_norm(o.transpose(0, 2, 1, 3), norm_w)
    y = o * jax.nn.silu(z.astype(jnp.float32).reshape(b, n, GDN_HEADS, GDN_DV))
    return y.reshape(b, n, GDN_V_W).astype(z.dtype)


def merge_branches(attn, gdn, gates, w_pa, w_pd, w_out):
    g_a, g_d = jnp.split(gates, 2, axis=-1)
    y = jax.nn.sigmoid(g_a) * (attn @ w_pa) + jax.nn.sigmoid(g_d) * (gdn @ w_pd)
    return y @ w_out


def conv_ffn(h, w_up, conv_w, conv_b, w_down):
    u = dwconv_centred(h @ w_up, conv_w, conv_b)
    g, val = jnp.split(u, 2, axis=-1)
    return (jax.nn.silu(g) * val) @ w_down


def hybrid_layer(x, ctx, c, c_ctx, w_mod, b_mod, w_in, q_norm_w, k_norm_w, conv_qkv_w, a_log, dt_bias,
                 gdn_norm_w, w_pa, w_pd, w_out, w_up, ffn_conv_w, ffn_conv_b, w_down, update_ctx):
    b, n, _ = x.shape
    cl = ctx.shape[1]
    mod_lat = jax.nn.silu(c) @ w_mod + b_mod
    mod_ctx = jax.nn.silu(c_ctx) @ w_mod + b_mod
    sh1, sc1, g1, sh2, sc2, g2 = [m[:, None, :] for m in jnp.split(mod_lat, 6, axis=-1)]
    csh1, csc1, cg1, csh2, csc2, cg2 = jnp.split(mod_ctx, 6, axis=-1)

    hx = modulate(rms_norm(x), sh1, sc1)
    hc = modulate(rms_norm(ctx), csh1, csc1)
    ak_x, av_x, qkv_x, db_x, da_x, aq_x, z_x, gate_x = split_cols(hx @ w_in)
    ak_c, av_c, qkv_c, db_c, da_c, *rest_c = split_cols(hc @ (w_in if update_ctx else w_in[:, :CTX_COLS]))

    cos, sin = axial_rope_tables(n)
    q_x = apply_axial_rope(rms_norm(aq_x.reshape(b, n, ATTN_HEADS, HEAD_DIM), q_norm_w), cos, sin)
    q_x = q_x.reshape(b, n, ATTN_KV_HEADS, ATTN_GROUP, HEAD_DIM)
    k_x = apply_axial_rope(rms_norm(ak_x.reshape(b, n, ATTN_KV_HEADS, HEAD_DIM), k_norm_w), cos, sin)
    v_x = av_x.reshape(b, n, ATTN_KV_HEADS, HEAD_DIM)
    k_c = rms_norm(ak_c.reshape(b, cl, ATTN_KV_HEADS, HEAD_DIM), k_norm_w)
    v_c = av_c.reshape(b, cl, ATTN_KV_HEADS, HEAD_DIM)
    attn_x = latent_attention(q_x, jnp.concatenate([k_c, k_x], axis=1), jnp.concatenate([v_c, v_x], axis=1))

    gdn_x_in = gdn_prepare(qkv_x, db_x, da_x, conv_qkv_w, a_log, dt_bias)
    gdn_c_in = gdn_prepare(qkv_c, db_c, da_c, conv_qkv_w, a_log, dt_bias)
    o_x, o_c = gdn_bidirectional(gdn_c_in, gdn_x_in, update_ctx)
    gdn_x = gdn_output(o_x, z_x, gdn_norm_w)

    x = x + g1 * merge_branches(attn_x, gdn_x, gate_x, w_pa, w_pd, w_out)
    x = x + g2 * conv_ffn(modulate(rms_norm(x), sh2, sc2), w_up, ffn_conv_w, ffn_conv_b, w_down)

    if update_ctx:
        aq_c, z_c, gate_c = rest_c
        q_c = rms_norm(aq_c.reshape(b, cl, ATTN_HEADS, HEAD_DIM), q_norm_w)
        q_c = q_c.reshape(b, cl, ATTN_KV_HEADS, ATTN_GROUP, HEAD_DIM)
        attn_c = sdpa_block(q_c, k_c, v_c).reshape(b, cl, ATTN_Q_W)
        gdn_c = gdn_output(o_c, z_c, gdn_norm_w)
        ctx = ctx + cg1 * merge_branches(attn_c, gdn_c, gate_c, w_pa, w_pd, w_out)
        ctx = ctx + cg2 * conv_ffn(modulate(rms_norm(ctx), csh2, csc2), w_up, ffn_conv_w, ffn_conv_b, w_down)
    return x, ctx


def setup_inputs(seed: int = 0) -> dict:
    key = jax.random.key(seed)
    ks = jax.random.split(key, 22)
    f32 = jnp.float32

    def dense(k, shape, fan_in, s=1.0):
        return s * (fan_in ** -0.5) * jax.random.normal(k, shape, f32)

    dt = jnp.exp(jax.random.uniform(ks[10], (DEPTH, 2, GDN_HEADS), f32,
                                    minval=math.log(1e-3), maxval=math.log(1e-1)))
    return {
        'x': jax.random.normal(ks[0], (BATCH, SEQ, D_MODEL), f32),
        'c': jax.random.normal(ks[1], (BATCH, D_MODEL), f32),
        'ctx': jax.random.normal(ks[2], (BATCH, CTX_LEN, D_MODEL), f32),
        'c_ctx': jax.random.normal(ks[3], (D_MODEL,), f32),
        'w_mod': dense(ks[4], (DEPTH, D_MODEL, 6 * D_MODEL), D_MODEL, 0.5),
        'b_mod': 0.02 * jax.random.normal(ks[5], (DEPTH, 6 * D_MODEL), f32),
        'w_in': dense(ks[6], (DEPTH, D_MODEL, IN_COLS), D_MODEL),
        'q_norm_w': 1.0 + 0.05 * jax.random.normal(ks[7], (DEPTH, HEAD_DIM), f32),
        'k_norm_w': 1.0 + 0.05 * jax.random.normal(ks[8], (DEPTH, HEAD_DIM), f32),
        'conv_qkv_w': dense(ks[9], (DEPTH, SHORT_CONV, GDN_CONV_W), SHORT_CONV),
        'a_log': jnp.log(jax.random.uniform(ks[11], (DEPTH, 2, GDN_HEADS), f32, minval=1.0, maxval=16.0)),
        'dt_bias': dt + jnp.log(-jnp.expm1(-dt)),
        'gdn_norm_w': 1.0 + 0.05 * jax.random.normal(ks[12], (DEPTH, GDN_DV), f32),
        'w_pa': dense(ks[13], (DEPTH, ATTN_Q_W, D_MODEL), ATTN_Q_W),
        'w_pd': dense(ks[14], (DEPTH, GDN_V_W, D_MODEL), GDN_V_W),
        'w_out': dense(ks[15], (DEPTH, D_MODEL, D_MODEL), D_MODEL),
        'w_up': dense(ks[16], (DEPTH, D_MODEL, 2 * D_FF), D_MODEL),
        'ffn_conv_w': dense(ks[17], (DEPTH, FFN_CONV, 2 * D_FF), FFN_CONV),
        'ffn_conv_b': 0.02 * jax.random.normal(ks[18], (DEPTH, 2 * D_FF), f32),
        'w_down': dense(ks[19], (DEPTH, D_FF, D_MODEL), D_FF),
        'final_norm_w': 1.0 + 0.05 * jax.random.normal(ks[20], (D_MODEL,), f32),
    }


def reference(x, c, ctx, c_ctx, w_mod, b_mod, w_in, q_norm_w, k_norm_w, conv_qkv_w, a_log, dt_bias,
              gdn_norm_w, w_pa, w_pd, w_out, w_up, ffn_conv_w, ffn_conv_b, w_down, final_norm_w):
    for layer in range(DEPTH):
        x, ctx = hybrid_layer(
            x, ctx, c, c_ctx, w_mod[layer], b_mod[layer], w_in[layer], q_norm_w[layer], k_norm_w[layer],
            conv_qkv_w[layer], a_log[layer], dt_bias[layer], gdn_norm_w[layer], w_pa[layer], w_pd[layer],
            w_out[layer], w_up[layer], ffn_conv_w[layer], ffn_conv_b[layer], w_down[layer],
            update_ctx=layer < DEPTH - 1)
    return rms_norm(x, final_norm_w)
```

```cpp
#include <hip/hip_runtime.h>
#include <cstdio>
#include <cstdint>

constexpr int DM = 1024, NB = 8, SEQ = 2048, CTXL = 256;
constexpr int M_LAT = NB * SEQ, M_CTX = NB * CTXL, M_ALL = M_LAT + M_CTX;
constexpr int KVLEN = CTXL + SEQ;
constexpr int DFF = 2816;
constexpr int NCH = KVLEN / 64;
constexpr float NORM_EPS = 1e-6f;
constexpr int WIN_ROWS = 7936, WIN_P2_TILES = 19, WIN_G_ROW0 = 4864;

constexpr size_t MiB = 1u << 20;
constexpr size_t WS_CTL = 0, CTL_ZERO_BYTES = 1 * MiB;
constexpr size_t WS_MOD = 1 * MiB;
constexpr size_t WS_ROPE = 1 * MiB + 256 * 1024;
constexpr size_t WS_HALO = 2 * MiB;
constexpr size_t WS_DBDA = 3 * MiB;
constexpr size_t WS_WIN = 6 * MiB;
constexpr size_t WS_K = 22 * MiB, WS_V = 31 * MiB;
constexpr size_t WS_A2 = 40 * MiB;
constexpr size_t WS_QKV = 104 * MiB;
constexpr size_t WS_TP = 212 * MiB;
constexpr size_t WS_VEC = 248 * MiB;
constexpr size_t WS_ZS = 104 * MiB;
constexpr size_t WS_GATES = 136 * MiB;
constexpr size_t WS_WM = 6 * MiB;
constexpr size_t WS_WO = 10 * MiB;
constexpr size_t WS_WUP = 12 * MiB;
constexpr size_t WS_WDN = 23 * MiB;
constexpr size_t WS_Y = 104 * MiB;
constexpr size_t WS_H2 = 29 * MiB;
constexpr size_t WS_ACT = 61 * MiB;
constexpr size_t WS_U = 149 * MiB;
constexpr size_t WS_SIDE = 136 * MiB;
constexpr size_t WS_END = 256 * MiB;
constexpr size_t DO_XN = 0, DO_O1 = 32 * MiB;

constexpr int CW_TMO = 0, CW_CODE = 1, CW_QUEUE = 64, CW_BAR = 4096;

constexpr int RING_BYTES = 131072;
constexpr int LDSX_OFF = RING_BYTES;
constexpr int LDSCTL_OFF = RING_BYTES + 12288, MISC_OFF = LDSCTL_OFF + 320;
constexpr int LDS_BYTES = 147456;

#define GAS __attribute__((address_space(1)))
#define LAS __attribute__((address_space(3)))
typedef unsigned short bf16;
typedef unsigned v4u __attribute__((ext_vector_type(4)));
typedef unsigned v2u __attribute__((ext_vector_type(2)));
typedef float f32x4 __attribute__((ext_vector_type(4)));
typedef float f32x2 __attribute__((ext_vector_type(2)));
typedef float f32x16 __attribute__((ext_vector_type(16)));
typedef short bf16x8 __attribute__((ext_vector_type(8)));
typedef short s16x4 __attribute__((ext_vector_type(4)));
typedef GAS unsigned gu32;
#define RLX_AGENT __ATOMIC_RELAXED, __HIP_MEMORY_SCOPE_AGENT
#define LDS_WAIT() asm volatile("s_waitcnt lgkmcnt(0)" ::: "memory")
#define VM_WAIT() asm volatile("s_waitcnt vmcnt(0)" ::: "memory")
#define SBAR() __builtin_amdgcn_sched_barrier(0)

__device__ __forceinline__ unsigned f2bf(float f) { unsigned u = __builtin_bit_cast(unsigned, f); return (u + 0x7fffu + ((u >> 16) & 1u)) >> 16; }
__device__ __forceinline__ unsigned pk2(float lo, float hi) { return f2bf(lo) | (f2bf(hi) << 16); }
__device__ __forceinline__ float bf2f(unsigned short h) { return __builtin_bit_cast(float, (unsigned)h << 16); }
__device__ __forceinline__ float bflo(unsigned w) { return __builtin_bit_cast(float, w << 16); }
__device__ __forceinline__ float bfhi(unsigned w) { return __builtin_bit_cast(float, w & 0xffff0000u); }
typedef __bf16 bf16x2_t __attribute__((ext_vector_type(2)));
__device__ __forceinline__ unsigned cvtpk(float lo, float hi) { f32x2 v = {lo, hi}; bf16x2_t b = __builtin_convertvector(v, bf16x2_t); return __builtin_bit_cast(unsigned, b); }
__device__ __forceinline__ float fast_exp(float x) { return __builtin_amdgcn_exp2f(x * 1.4426950408889634f); }
__device__ __forceinline__ float sigmoidf_(float x) { return __builtin_amdgcn_rcpf(1.f + fast_exp(-x)); }
__device__ __forceinline__ float siluf_(float x) { return x * sigmoidf_(x); }
__device__ __forceinline__ float wave_sum(float v) {
#pragma unroll
    for (int o = 1; o < 64; o <<= 1) v += __shfl_xor(v, o);
    return v;
}
__device__ __forceinline__ int tidx() { int t = threadIdx.x; asm volatile("" : "+v"(t)); return t; }
#define XB_TMO      128
#define XB_XCNT(j)  (256  + 64 * (j))
#define XB_XSUB(j)  (1280 + 64 * (j))
#define XB_XGEN(j)  (2304 + 64 * (j))
#define XB_TOP      3328
#define XB_TOPGEN   3392
#define XCD_BAR_WORDS 3456
#define XB_SPIN_CAP (1u << 18)

__device__ __forceinline__ unsigned xb_ld(unsigned* p)              { return __hip_atomic_load(p, __ATOMIC_RELAXED, __HIP_MEMORY_SCOPE_AGENT); }
__device__ __forceinline__ unsigned xb_add(unsigned* p, unsigned v) { return __hip_atomic_fetch_add(p, v, __ATOMIC_RELAXED, __HIP_MEMORY_SCOPE_AGENT); }
__device__ __forceinline__ unsigned xb_xcc_id() { return (unsigned)__builtin_amdgcn_s_getreg((3 << 11) | 20) & 0xFu; }
#define XB_SPIN(cond, bar) do { unsigned _sp = 0; while (cond) { __builtin_amdgcn_s_sleep(1); \
    if ((++_sp & 255u) == 0u) { if (xb_ld(&(bar)[XB_TMO])) break; if (_sp > XB_SPIN_CAP) { atomicAdd(&(bar)[XB_TMO], 1u); break; } } } } while (0)

struct XcdBarrier {
    unsigned* bar; unsigned x;
    volatile LAS unsigned* st;
};

__device__ __forceinline__ XcdBarrier xcd_barrier_post(unsigned* bar, volatile LAS unsigned* st) {
    XcdBarrier b; b.bar = bar; b.x = xb_xcc_id(); b.st = st;
    if (tidx() == 0) (void)xb_add(&bar[XB_XCNT(b.x)], 1u);
    return b;
}
__device__ __forceinline__ void xcd_barrier_complete(unsigned* bar, unsigned x, unsigned& nloc, unsigned& nx) {
    const unsigned G = gridDim.x * gridDim.y * gridDim.z;
    unsigned sum, cnt, mine, sp = 0u;
    for (;;) {
        sum = 0u; cnt = 0u; mine = 0u;
#pragma unroll
        for (unsigned j = 0; j < 16; ++j) { const unsigned c = xb_ld(&bar[XB_XCNT(j)]); sum += c; cnt += (c > 0u) ? 1u : 0u; mine = (j == x) ? c : mine; }
        if (sum == G) break;
        __builtin_amdgcn_s_sleep(1);
        if ((++sp & 255u) == 0u) { if (xb_ld(&bar[XB_TMO])) break; if (sp > XB_SPIN_CAP) { atomicAdd(&bar[XB_TMO], 1u); break; } }
    }
    nloc = mine > 0u ? mine : 1u; nx = cnt > 0u ? cnt : 1u;
}

__device__ __forceinline__ void xcd_barrier(const XcdBarrier& b) {
    asm volatile("s_waitcnt vmcnt(0)" ::: "memory");
    __syncthreads();
    if (tidx() == 0) {
        unsigned* bar = b.bar;
        __builtin_amdgcn_s_waitcnt(0);
        unsigned nloc = b.st[0], nx = b.st[1];
        if (nloc == 0u) { xcd_barrier_complete(bar, b.x, nloc, nx); b.st[0] = nloc; b.st[1] = nx; }
        const unsigned old = xb_add(&bar[XB_XSUB(b.x)], 1u);
        const unsigned gen = old / nloc;
        if (old + 1u == (gen + 1u) * nloc) {
            __builtin_amdgcn_fence(__ATOMIC_RELEASE, "agent");
            asm volatile("s_waitcnt vmcnt(0)" ::: "memory");
            const unsigned og = xb_add(&bar[XB_TOP], 1u);
            const unsigned tg = og / nx;
            if (og + 1u == (tg + 1u) * nx) xb_add(&bar[XB_TOPGEN], 1u);
            else XB_SPIN(xb_ld(&bar[XB_TOPGEN]) == tg, bar);
            __builtin_amdgcn_fence(__ATOMIC_ACQUIRE, "agent");
            xb_add(&bar[XB_XGEN(b.x)], 1u);
            asm volatile("s_waitcnt vmcnt(0)" ::: "memory");
        } else {
            XB_SPIN(xb_ld(&bar[XB_XGEN(b.x)]) == gen, bar);
            __builtin_amdgcn_fence(__ATOMIC_ACQUIRE, "agent");
            asm volatile("s_waitcnt vmcnt(0)" ::: "memory");
        }
    }
    __syncthreads();
}
namespace pg8 {
#define PG8_LAS __attribute__((address_space(3)))
typedef unsigned short bf16_t;
typedef unsigned u32x4 __attribute__((ext_vector_type(4)));
constexpr int BM = 256, BK = 64, HALF = 128, HTB = HALF * BK * 2  , STAGE_BYTES = 8 * HTB, NXCD = 8, WGM = 8;
__host__ __device__ __forceinline__ int lds_byte(int r, int c) { const int st = (r >> 4) * 2 + (c >> 5), rr = r & 15, cc = c & 31, ob = rr * 64 + cc * 2; return st * 1024 + (ob ^ (((ob >> 9) & 1) << 5)); }
__host__ __device__ __forceinline__ void stage_rc(int b, int& R, int& C) { const int st = b / 1024, sb = b % 1024, swz = sb ^ (((sb >> 9) & 1) << 5); R = (st >> 1) * 16 + swz / 64; C = (st & 1) * 32 + (swz % 64) / 2; }
__host__ __device__ __forceinline__ int perm32(int rho) { const int n = rho >> 4, i = rho & 15; return 8 * (i >> 2) + 4 * n + (i & 3); }
struct Unit { int pm, pn; };
struct Gemm { const bf16_t* A; const bf16_t* Bt; int K, lda, ldb; };
struct StaticOrder {
    int nM, nN, nwg, G, c;
    __host__ __device__ void init(int nM_, int nN_, int G_, int c_) { nM = nM_; nN = nN_; nwg = nM * nN; G = G_; c = c_; }
    __host__ __device__ bool next(int i, Unit& u) const {
        const long L = (long)i * G + c; if (L >= nwg) return false;
        int wgid = (int)L; { const int q = nwg / NXCD, r = nwg % NXCD, xcd = wgid % NXCD, off = wgid / NXCD; wgid = (xcd < r ? xcd * (q + 1) : r * (q + 1) + (xcd - r) * q) + off; }
        const int nig = WGM * nN, gid = wgid / nig, fm = gid * WGM, gsz = (nM - fm) < WGM ? (nM - fm) : WGM;
        u.pm = fm + ((wgid % nig) % gsz); u.pn = (wgid % nig) / gsz; return true;
    }
    __device__ __forceinline__ void a_ready(const Unit&) const {}
    __device__ __forceinline__ void done(const Unit&) const {}
};
template <class Epi, class Sched, bool ALIGN_EPI = false, bool SP2 = false>
__device__ __forceinline__ void gemm_phase(PG8_LAS unsigned char* lds, const Gemm g, const Sched& S, const Epi& E) {
    const int tid = tidx(), wid = __builtin_amdgcn_readfirstlane(tid >> 6), lane = tid & 63, wr = wid >> 2, wc = wid & 3, fr = lane & 15, fq = lane >> 4;
    const int K = g.K, nt = K / BK, lda = g.lda, ldb = g.ldb;
    unsigned voffA[2], voffB[2];
#pragma unroll
    for (int i = 0; i < 2; ++i) { int R, C; stage_rc(tid * 16 + i * 8192, R, C); const int Rb = Epi::PERM ? ((R & ~31) + perm32(R & 31)) : R;
        voffA[i] = (unsigned)(R * lda + C) * 2u; voffB[i] = (unsigned)(Rb * ldb + C) * 2u; }
    const size_t kstep = (size_t)(BK * 2);
    const size_t hstepA = (size_t)HALF * lda * 2, hstepB = (size_t)HALF * ldb * 2;
    const size_t tstepA = 2 * hstepA, tstepB = 2 * hstepB;
    const unsigned ldsw = (unsigned)wid * 1024u;
    const int aoff = lds_byte(wr * 64 + fr, fq * 8), boff = lds_byte(wc * 32 + fr, fq * 8);
#define PG8_SA(b, h) (((b) * 2 + (h)) * HTB)
#define PG8_SB(b, h) ((4 + (b) * 2 + (h)) * HTB)
#define PG8_STAGE(bufoff, gbase, voff) do { _Pragma("unroll") for (int _i = 0; _i < 2; ++_i) \
        __builtin_amdgcn_global_load_lds((const unsigned*)((const char*)(gbase) + (voff)[_i]), (PG8_LAS unsigned*)(lds + (bufoff) + ldsw + _i * 8192), 16, 0, 0); } while (0)
#define PG8_LDA(dst, b, h) do { _Pragma("unroll") for (int m = 0; m < 4; ++m) _Pragma("unroll") for (int k = 0; k < 2; ++k) dst[m][k] = *(const PG8_LAS bf16x8*)(lds + PG8_SA(b, h) + aoff + m * 2048 + k * 1024); } while (0)
#define PG8_LDB(dst, b, h) do { _Pragma("unroll") for (int n = 0; n < 2; ++n) _Pragma("unroll") for (int k = 0; k < 2; ++k) dst[n][k] = *(const PG8_LAS bf16x8*)(lds + PG8_SB(b, h) + boff + n * 2048 + k * 1024); } while (0)
#define PG8_MMA(ai, bj, At, Bt) do { __builtin_amdgcn_s_setprio(1); _Pragma("unroll") for (int m = 0; m < 4; ++m) _Pragma("unroll") for (int n = 0; n < 2; ++n) _Pragma("unroll") for (int k = 0; k < 2; ++k) \
        acc[ai][bj][m][n] = __builtin_amdgcn_mfma_f32_16x16x32_bf16(Bt[n][k], At[m][k], acc[ai][bj][m][n], 0, 0, 0); __builtin_amdgcn_s_setprio(0); } while (0)
#define PG8_WAIT_V(n) asm volatile("s_waitcnt vmcnt(" #n ")" ::: "memory")
#define PG8_WAIT_L(n) asm volatile("s_waitcnt lgkmcnt(" #n ")" ::: "memory")
#define PG8_BAR __builtin_amdgcn_s_barrier()
#define PG8_SCHED __builtin_amdgcn_sched_barrier(0)
    Unit cur, nxt; int ui = 0;
    if (!S.next(0, cur)) return;
    f32x4 acc[2][2][4][2];
#pragma unroll
    for (int a = 0; a < 2; ++a)
#pragma unroll
        for (int b = 0; b < 2; ++b)
#pragma unroll
            for (int m = 0; m < 4; ++m)
#pragma unroll
                for (int n = 0; n < 2; ++n) acc[a][b][m][n] = (f32x4){0.f, 0.f, 0.f, 0.f};
    bf16x8 At[4][2], B0[2][2], B1[2][2];
    const char* cA = (const char*)g.A + (size_t)cur.pm * tstepA; const char* cB = (const char*)g.Bt + (size_t)cur.pn * tstepB;
    S.a_ready(cur);
    if constexpr (SP2) {
        PG8_STAGE(PG8_SB(0, 0), cB, voffB); PG8_STAGE(PG8_SB(0, 1), cB + hstepB, voffB); PG8_STAGE(PG8_SA(0, 0), cA, voffA); PG8_STAGE(PG8_SA(0, 1), cA + hstepA, voffA);
        if (wr == 1) PG8_BAR;
        PG8_WAIT_V(2); PG8_BAR;
        PG8_STAGE(PG8_SB(1, 0), cB + kstep, voffB); PG8_STAGE(PG8_SA(1, 0), cA + kstep, voffA); PG8_STAGE(PG8_SB(1, 1), cB + hstepB + kstep, voffB);
        PG8_WAIT_V(6); PG8_BAR;
    } else {
        PG8_STAGE(PG8_SB(0, 0), cB, voffB); PG8_STAGE(PG8_SA(0, 0), cA, voffA); PG8_STAGE(PG8_SB(0, 1), cB + hstepB, voffB); PG8_STAGE(PG8_SA(0, 1), cA + hstepA, voffA);
        if (wr == 1) PG8_BAR;
        PG8_WAIT_V(4); PG8_BAR;
        PG8_STAGE(PG8_SB(1, 0), cB + kstep, voffB); PG8_STAGE(PG8_SA(1, 0), cA + kstep, voffA); PG8_STAGE(PG8_SB(1, 1), cB + hstepB + kstep, voffB);
        PG8_WAIT_V(6); PG8_BAR;
    }
    for (;;) {
        const bool has_next = S.next(ui + 1, nxt);
        const char* nA = has_next ? (const char*)g.A + (size_t)nxt.pm * tstepA : cA; const char* nB = has_next ? (const char*)g.Bt + (size_t)nxt.pn * tstepB : cB;
        for (int t = 0; t < nt; t += 2) {
            const bool last = (t == nt - 2);
            const char* a1 = cA + (size_t)(t + 1) * kstep;
            const char* a2 = last ? nA : cA + (size_t)(t + 2) * kstep; const char* b2 = last ? nB : cB + (size_t)(t + 2) * kstep;
            const char* a3 = a2 + kstep; const char* b3 = b2 + kstep;
            if (last && has_next) S.a_ready(nxt);
            if constexpr (SP2) {
            PG8_LDB(B0, 0, 0); PG8_LDB(B1, 0, 1); PG8_SCHED; PG8_LDA(At, 0, 0); PG8_STAGE(PG8_SA(1, 1), a1 + hstepA, voffA);
            PG8_WAIT_V(8); PG8_WAIT_L(0); PG8_BAR; PG8_MMA(0, 0, At, B0); PG8_MMA(0, 1, At, B1); PG8_BAR; PG8_SCHED;
            PG8_LDA(At, 0, 1); PG8_STAGE(PG8_SB(0, 0), b2, voffB); PG8_STAGE(PG8_SB(0, 1), b2 + hstepB, voffB); PG8_STAGE(PG8_SA(0, 0), a2, voffA);
            PG8_WAIT_V(8); PG8_WAIT_L(0); PG8_BAR; PG8_MMA(1, 0, At, B0); PG8_MMA(1, 1, At, B1); PG8_BAR; PG8_SCHED;
            PG8_LDB(B0, 1, 0); PG8_LDB(B1, 1, 1); PG8_SCHED; PG8_LDA(At, 1, 0); PG8_STAGE(PG8_SA(0, 1), a2 + hstepA, voffA);
            PG8_WAIT_V(8); PG8_WAIT_L(0); PG8_BAR; PG8_MMA(0, 0, At, B0); PG8_MMA(0, 1, At, B1); PG8_BAR; PG8_SCHED;
            PG8_LDA(At, 1, 1); PG8_STAGE(PG8_SB(1, 0), b3, voffB); PG8_STAGE(PG8_SB(1, 1), b3 + hstepB, voffB); PG8_STAGE(PG8_SA(1, 0), a3, voffA);
            PG8_WAIT_V(8); PG8_WAIT_L(0); PG8_BAR; PG8_MMA(1, 0, At, B0); PG8_MMA(1, 1, At, B1); PG8_BAR; PG8_SCHED;
            } else {
            PG8_LDB(B0, 0, 0); PG8_SCHED; PG8_LDA(At, 0, 0); PG8_STAGE(PG8_SA(1, 1), a1 + hstepA, voffA);
            PG8_WAIT_L(8); PG8_BAR; PG8_WAIT_L(0); PG8_MMA(0, 0, At, B0); PG8_BAR; PG8_SCHED;
            PG8_LDB(B1, 0, 1); PG8_STAGE(PG8_SB(0, 0), b2, voffB);
            PG8_BAR; PG8_WAIT_L(0); PG8_MMA(0, 1, At, B1); PG8_BAR;
            PG8_LDA(At, 0, 1); PG8_STAGE(PG8_SA(0, 0), a2, voffA);
            PG8_BAR; PG8_WAIT_L(0); PG8_MMA(1, 0, At, B0); PG8_BAR; PG8_SCHED;
            PG8_STAGE(PG8_SB(0, 1), b2 + hstepB, voffB);
            PG8_WAIT_V(6); PG8_BAR; PG8_MMA(1, 1, At, B1); PG8_BAR;
            PG8_LDB(B0, 1, 0); PG8_SCHED; PG8_LDA(At, 1, 0); PG8_STAGE(PG8_SA(0, 1), a2 + hstepA, voffA);
            PG8_WAIT_L(8); PG8_BAR; PG8_WAIT_L(0); PG8_MMA(0, 0, At, B0); PG8_BAR; PG8_SCHED;
            PG8_LDB(B1, 1, 1); PG8_STAGE(PG8_SB(1, 0), b3, voffB);
            PG8_BAR; PG8_WAIT_L(0); PG8_MMA(0, 1, At, B1); PG8_BAR;
            PG8_LDA(At, 1, 1); PG8_STAGE(PG8_SA(1, 0), a3, voffA);
            PG8_BAR; PG8_WAIT_L(0); PG8_MMA(1, 0, At, B0); PG8_BAR; PG8_SCHED;
            PG8_STAGE(PG8_SB(1, 1), b3 + hstepB, voffB);
            PG8_WAIT_V(6); PG8_BAR; PG8_MMA(1, 1, At, B1); PG8_BAR;
            }
        }
        if constexpr (ALIGN_EPI) { if (wr == 0) PG8_BAR; }
        if constexpr (!Epi::AFTER_DRAIN) { E(acc, cur, wr, wc, fr, fq); S.done(cur); }
        if (!has_next) break;
#pragma unroll
        for (int a = 0; a < 2; ++a)
#pragma unroll
            for (int b = 0; b < 2; ++b)
#pragma unroll
                for (int m = 0; m < 4; ++m)
#pragma unroll
                    for (int n = 0; n < 2; ++n) acc[a][b][m][n] = (f32x4){0.f, 0.f, 0.f, 0.f};
        cur = nxt; cA = nA; cB = nB; ++ui;
        if constexpr (ALIGN_EPI) { if (wr == 1) PG8_BAR; }
    }
    PG8_WAIT_V(0);
    if constexpr (!ALIGN_EPI) { if (wr == 0) PG8_BAR; }
    PG8_BAR;
    if constexpr (Epi::AFTER_DRAIN) { E.fused(acc, cur, wr, wc, fr, fq, lds, wid, lane); S.done(cur); }
#undef PG8_SA
#undef PG8_SB
#undef PG8_STAGE
#undef PG8_LDA
#undef PG8_LDB
#undef PG8_MMA
#undef PG8_WAIT_V
#undef PG8_WAIT_L
#undef PG8_BAR
#undef PG8_SCHED
}
}
namespace att {
constexpr int D = 128, NW = 8, QBLK = 32, KVBLK = 64;
constexpr float SCALE = 0.088388347648318440f;
constexpr float THR = 8.f;
constexpr int LDQ = 2048, LDK = 256, LDO = 2048;
constexpr size_t SHM_V = KVBLK * D * 2, SHM_K = KVBLK * D * 2, SHM_ATTN = 2 * SHM_V + 2 * SHM_K + NW * 64 * 4;
#define KSWZ(row, colB) ((row) * 256 + ((colB) ^ (((row) & 7) << 4)))
__device__ __forceinline__ int crow(int r, int hi) { return (r & 3) + 8 * (r >> 2) + 4 * hi; }
__device__ __forceinline__ void partialSM(f32x16& p0, f32x16& p1, float& m_reg, float& mn, float& alpha) {
  constexpr float C = SCALE * 1.4426950408889634f;
  float pmax = p0[0];
#pragma unroll
  for (int r = 1; r < 16; ++r) pmax = fmaxf(pmax, p0[r]);
#pragma unroll
  for (int r = 0; r < 16; ++r) pmax = fmaxf(pmax, p1[r]);
  { auto rr = __builtin_amdgcn_permlane32_swap(__float_as_uint(pmax), __float_as_uint(pmax), false, false);
    pmax = fmaxf(__uint_as_float(rr[0]), __uint_as_float(rr[1])); }
  if (__builtin_expect(__all(pmax - m_reg <= THR / SCALE), 1)) { mn = m_reg; alpha = 1.f; }
  else { mn = fmaxf(m_reg, pmax); alpha = __builtin_amdgcn_exp2f((m_reg - mn) * C); m_reg = mn; }
  float mnC = -mn * C;
#pragma unroll
  for (int r = 0; r < 16; ++r) p0[r] = fmaf(p0[r], C, mnC);
#pragma unroll
  for (int r = 0; r < 16; ++r) p1[r] = fmaf(p1[r], C, mnC);
#pragma unroll
  for (int r = 0; r < 16; ++r) p0[r] = __builtin_amdgcn_exp2f(p0[r]);
}
__device__ __forceinline__ void finishSM(f32x16& p0, f32x16& p1, float alpha, float& l_reg, bf16x8& pa0, bf16x8& pa1, bf16x8& pa2, bf16x8& pa3) {
#pragma unroll
  for (int r = 0; r < 16; ++r) p1[r] = __builtin_amdgcn_exp2f(p1[r]);
  float ps = 0;
#pragma unroll
  for (int r = 0; r < 16; ++r) ps += p0[r];
#pragma unroll
  for (int r = 0; r < 16; ++r) ps += p1[r];
  { auto rr = __builtin_amdgcn_permlane32_swap(__float_as_uint(ps), __float_as_uint(ps), false, false);
    ps = __uint_as_float(rr[0]) + __uint_as_float(rr[1]); }
  l_reg = l_reg * alpha + ps;
#define PK4(P, BASE, OUT) do { unsigned a0 = cvtpk(P[BASE + 0], P[BASE + 1]), a1 = cvtpk(P[BASE + 2], P[BASE + 3]);   \
    unsigned b0 = cvtpk(P[BASE + 4], P[BASE + 5]), b1 = cvtpk(P[BASE + 6], P[BASE + 7]);                              \
    auto r0 = __builtin_amdgcn_permlane32_swap(a0, b0, false, false); auto r1 = __builtin_amdgcn_permlane32_swap(a1, b1, false, false); \
    v4u w = {r0[0], r1[0], r0[1], r1[1]}; OUT = __builtin_bit_cast(bf16x8, w); } while (0)
  PK4(p0, 0, pa0); PK4(p0, 8, pa1); PK4(p1, 0, pa2); PK4(p1, 8, pa3);
#undef PK4
}
__device__ __forceinline__ void qkt(f32x16& p0, f32x16& p1, const bf16* Ks, const bf16x8* qr, int r32, int hi) {
  p0 = f32x16{}; p1 = f32x16{};
#pragma unroll
  for (int d0 = 0; d0 < 8; ++d0) { int cb = (d0 * 16 + hi * 8) * 2;
    bf16x8 b0 = *reinterpret_cast<const bf16x8*>((const char*)Ks + KSWZ(r32, cb));
    bf16x8 b1 = *reinterpret_cast<const bf16x8*>((const char*)Ks + KSWZ(32 + r32, cb));
    p0 = __builtin_amdgcn_mfma_f32_32x32x16_bf16(b0, qr[d0], p0, 0, 0, 0);
    p1 = __builtin_amdgcn_mfma_f32_32x32x16_bf16(b1, qr[d0], p1, 0, 0, 0); }
}
__device__ __forceinline__ int v_st(int k, int c) { const int kk = (k & ~0xC) | ((k & 4) << 1) | ((k & 8) >> 1); return ((kk >> 3) * 4 + (c >> 5)) * 512 + ((kk & 7) * 32 + (c & 31)) * 2; }
__device__ __forceinline__ int v_rd_base(int lane) { return ((lane & 3) << 3) | (((lane >> 2) & 3) << 6) | (((lane >> 4) & 1) << 5) | (((lane >> 5) & 1) << 8); }
constexpr int v_rd_off(int d0, int ks, int half) { return d0 * 512 + ks * 4096 + half * 2048; }
template <int OFF> __device__ __forceinline__ s16x4 tr_read(int vb) {
  s16x4 r; asm volatile("ds_read_b64_tr_b16 %0, %1 offset:%2" : "=&v"(r) : "v"(vb), "i"(OFF) : "memory"); return r;
}
template <int D0> __device__ __forceinline__ void pv_one(f32x16& od, int vb, bf16x8 pa0, bf16x8 pa1, bf16x8 pa2, bf16x8 pa3) {
  const s16x4 l0 = tr_read<v_rd_off(D0, 0, 0)>(vb), h0 = tr_read<v_rd_off(D0, 0, 1)>(vb), l1 = tr_read<v_rd_off(D0, 1, 0)>(vb), h1 = tr_read<v_rd_off(D0, 1, 1)>(vb);
  const s16x4 l2 = tr_read<v_rd_off(D0, 2, 0)>(vb), h2 = tr_read<v_rd_off(D0, 2, 1)>(vb), l3 = tr_read<v_rd_off(D0, 3, 0)>(vb), h3 = tr_read<v_rd_off(D0, 3, 1)>(vb);
  asm volatile("s_waitcnt lgkmcnt(0)" ::: "memory"); SBAR();
#define PK(L, H) (bf16x8){L[0], L[1], L[2], L[3], H[0], H[1], H[2], H[3]}
  od = __builtin_amdgcn_mfma_f32_32x32x16_bf16(pa0, PK(l0, h0), od, 0, 0, 0);
  od = __builtin_amdgcn_mfma_f32_32x32x16_bf16(pa1, PK(l1, h1), od, 0, 0, 0);
  od = __builtin_amdgcn_mfma_f32_32x32x16_bf16(pa2, PK(l2, h2), od, 0, 0, 0);
  od = __builtin_amdgcn_mfma_f32_32x32x16_bf16(pa3, PK(l3, h3), od, 0, 0, 0);
#undef PK
}
__device__ __forceinline__ void pv_d0(f32x16* o, int vb, bf16x8 pa0, bf16x8 pa1, bf16x8 pa2, bf16x8 pa3) {
  pv_one<0>(o[0], vb, pa0, pa1, pa2, pa3); pv_one<1>(o[1], vb, pa0, pa1, pa2, pa3); pv_one<2>(o[2], vb, pa0, pa1, pa2, pa3); pv_one<3>(o[3], vb, pa0, pa1, pa2, pa3);
}
__device__ __forceinline__ void attn_unit(bf16* Qb, const bf16* __restrict__ Kh, const bf16* __restrict__ Vh, int tpos0, const float* __restrict__ qnw, const float* __restrict__ rope, int seq, char* lds) {
  const int tid = tidx(), wid = tid >> 6, lane = tid & 63, r32 = lane & 31, hi = lane >> 5;
  bf16* V_lds = (bf16*)lds; bf16* K_lds = (bf16*)(lds + 2 * SHM_V);
  float* ws = (float*)(lds + 2 * SHM_V + 2 * SHM_K) + wid * 64; float* li_l = ws; float* al_l = ws + 32;
  float m_reg = -1e30f, l_reg = 0; f32x16 o[4] = {}; bf16x8 qr[8];
  {
    const bf16* Qw = Qb + (long)(wid * QBLK + r32) * LDQ + hi * 8;
    float xf[8][8]; float ss = 0.f;
#pragma unroll
    for (int d0 = 0; d0 < 8; ++d0) { const v4u raw = *reinterpret_cast<const v4u*>(Qw + d0 * 16);
#pragma unroll
      for (int e = 0; e < 4; ++e) { xf[d0][2 * e] = bflo(raw[e]); xf[d0][2 * e + 1] = bfhi(raw[e]); } }
#pragma unroll
    for (int d0 = 0; d0 < 8; ++d0)
#pragma unroll
      for (int e = 0; e < 8; ++e) ss += xf[d0][e] * xf[d0][e];
    { auto rr = __builtin_amdgcn_permlane32_swap(__float_as_uint(ss), __float_as_uint(ss), false, false); ss = __uint_as_float(rr[0]) + __uint_as_float(rr[1]); }
    const float rstd = 1.0f / sqrtf(ss * (1.0f / 128.0f) + NORM_EPS);
#pragma unroll
    for (int d0 = 0; d0 < 8; ++d0) { const f32x4 w0 = *(const f32x4*)(qnw + d0 * 16 + hi * 8), w1 = *(const f32x4*)(qnw + d0 * 16 + hi * 8 + 4);
#pragma unroll
      for (int e = 0; e < 4; ++e) { xf[d0][e] *= rstd * w0[e]; xf[d0][4 + e] *= rstd * w1[e]; } }
    const int t = tpos0 + wid * QBLK + r32, prow = t >> 6, pcol = t & 63;
#pragma unroll
    for (int ax = 0; ax < 2; ++ax) { const float* tb = rope + (size_t)(ax ? pcol : prow) * 64;
#pragma unroll
      for (int dd = 0; dd < 2; ++dd) { const int d0 = 4 * ax + dd;
#pragma unroll
        for (int e = 0; e < 8; ++e) { const f32x2 cs = *(const f32x2*)(tb + 2 * (16 * dd + 8 * hi + e));
          const float x1 = xf[d0][e], x2 = xf[d0 + 2][e]; xf[d0][e] = x1 * cs.x - x2 * cs.y; xf[d0 + 2][e] = x2 * cs.x + x1 * cs.y; } } }
#pragma unroll
    for (int d0 = 0; d0 < 8; ++d0) { v4u w = {cvtpk(xf[d0][0], xf[d0][1]), cvtpk(xf[d0][2], xf[d0][3]), cvtpk(xf[d0][4], xf[d0][5]), cvtpk(xf[d0][6], xf[d0][7])}; qr[d0] = __builtin_bit_cast(bf16x8, w); }
  }
  const int sr = tid >> 4, sc = (tid & 15) * 8, vst0 = v_st(sr, sc), vst1 = v_st(32 + sr, sc);
  const int vb0 = (int)(uintptr_t)V_lds + v_rd_base(lane);
  struct { bf16x8 vs0, vs1, ks0, ks1; } sr_[2];
#define SLOAD(i, k0) do { sr_[i].vs0 = *(const bf16x8*)(&Vh[(long)((k0) + sr) * LDK + sc]); sr_[i].vs1 = *(const bf16x8*)(&Vh[(long)((k0) + 32 + sr) * LDK + sc]); \
    sr_[i].ks0 = *(const bf16x8*)(&Kh[(long)((k0) + sr) * LDK + sc]); sr_[i].ks1 = *(const bf16x8*)(&Kh[(long)((k0) + 32 + sr) * LDK + sc]); } while (0)
#define SWRITE(b, i) do { *(bf16x8*)((char*)V_lds + (b) * SHM_V + vst0) = sr_[i].vs0;          \
    *(bf16x8*)((char*)V_lds + (b) * SHM_V + vst1) = sr_[i].vs1; int kc = sc * 2;               \
    *(bf16x8*)((char*)K_lds + (b) * SHM_K + KSWZ(sr, kc)) = sr_[i].ks0;                       \
    *(bf16x8*)((char*)K_lds + (b) * SHM_K + KSWZ(32 + sr, kc)) = sr_[i].ks1; } while (0)
#define SWAIT() asm volatile("s_waitcnt vmcnt(4)" ::: "memory")
#define RESC(a) do { if (__any((a) < 1.f)) { if (hi == 0) al_l[r32] = (a); asm volatile("s_waitcnt lgkmcnt(0)" ::: "memory"); \
    _Pragma("unroll") for (int d = 0; d < 4; ++d) _Pragma("unroll") for (int r = 0; r < 16; ++r) o[d][r] *= al_l[crow(r, hi)]; } } while (0)
  f32x16 pA0, pA1, pB0, pB1; float mnA, mnB, alA, alB; bf16x8 pa0, pa1, pa2, pa3; const int NT = seq / KVBLK;
  constexpr int SE = 0, SO = 1;
  SLOAD(SE, 0); asm volatile("s_waitcnt vmcnt(0)" ::: "memory"); SWRITE(0, SE); __syncthreads();
  qkt(pA0, pA1, K_lds, qr, r32, hi); partialSM(pA0, pA1, m_reg, mnA, alA);
  SLOAD(SO, KVBLK); if (2 < NT) SLOAD(SE, 2 * KVBLK);
  SWAIT(); SWRITE(1, SO); __syncthreads();
  for (int j = 1; j + 1 < NT; j += 2) {
    SBAR(); qkt(pB0, pB1, (bf16*)((char*)K_lds + SHM_K), qr, r32, hi);
    finishSM(pA0, pA1, alA, l_reg, pa0, pa1, pa2, pa3); SBAR();
    SLOAD(SO, (j + 2) * KVBLK); SBAR();
    pv_d0(o, vb0, pa0, pa1, pa2, pa3); partialSM(pB0, pB1, m_reg, mnB, alB);
    __syncthreads(); SWAIT(); SWRITE(0, SE);
    RESC(alB); __syncthreads();
    SBAR(); qkt(pA0, pA1, K_lds, qr, r32, hi);
    finishSM(pB0, pB1, alB, l_reg, pa0, pa1, pa2, pa3); SBAR();
    if (j + 3 < NT) SLOAD(SE, (j + 3) * KVBLK); SBAR();
    pv_d0(o, vb0 + (int)SHM_V, pa0, pa1, pa2, pa3); partialSM(pA0, pA1, m_reg, mnA, alA);
    __syncthreads(); SWAIT(); SWRITE(1, SO);
    RESC(alA); __syncthreads();
  }
  SBAR(); qkt(pB0, pB1, (bf16*)((char*)K_lds + SHM_K), qr, r32, hi);
  finishSM(pA0, pA1, alA, l_reg, pa0, pa1, pa2, pa3); SBAR();
  pv_d0(o, vb0, pa0, pa1, pa2, pa3); partialSM(pB0, pB1, m_reg, mnB, alB);
  __syncthreads(); RESC(alB);
  finishSM(pB0, pB1, alB, l_reg, pa0, pa1, pa2, pa3); SBAR();
  pv_d0(o, vb0 + (int)SHM_V, pa0, pa1, pa2, pa3);
  if (hi == 0) li_l[r32] = l_reg; asm volatile("s_waitcnt lgkmcnt(0)" ::: "memory");
  float rli[16];
#pragma unroll
  for (int r = 0; r < 16; ++r) rli[r] = __builtin_amdgcn_rcpf(li_l[crow(r, hi)]);
  bf16* Ow = Qb + (long)(wid * QBLK) * LDO;
#pragma unroll
  for (int r = 0; r < 16; ++r) { int orow = crow(r, hi);
#pragma unroll
    for (int d0 = 0; d0 < 4; ++d0) Ow[(long)orow * LDO + d0 * 32 + r32] = (bf16)f2bf(o[d0][r] * rli[r]); }
  asm volatile("s_waitcnt vmcnt(0)" ::: "memory");
#undef SLOAD
#undef SWRITE
#undef SWAIT
#undef RESC
}
#undef KSWZ
}
namespace gdn {
__device__ __forceinline__ int crow(int r, int hi) { return (r & 3) + 8 * (r >> 2) + 4 * hi; }
__device__ __forceinline__ unsigned off_b(unsigned row, unsigned ch) { return 256u * row + 16u * (ch ^ (((row & 3) << 2) | ((row >> 2) & 3))); }
__device__ __forceinline__ unsigned off_t(unsigned row, unsigned ch) { return 128u * row + 16u * (ch ^ ((row >> 1) & 7)); }
__host__ __device__ constexpr int swz16(int p) { return (p & ~12) | ((p & 4) << 1) | ((p & 8) >> 1); }
typedef short v4i16_t __attribute__((ext_vector_type(4)));
__device__ __forceinline__ float readlane_f(float x, int l) { return __builtin_bit_cast(float, __builtin_amdgcn_readlane(__builtin_bit_cast(int, x), l)); }
__device__ __forceinline__ s16x4 vtr(LAS unsigned char* p) { return __builtin_bit_cast(s16x4, __builtin_amdgcn_ds_read_tr16_b64_v4i16((LAS v4i16_t*)p)); }
__device__ __forceinline__ bf16x8 lda16(LAS unsigned char* p) { return *(const LAS bf16x8*)p; }

struct PrepCtx {
    bf16* QKV; const bf16* HALO; const float* DBDA; const float* convw; const float* a_log; const float* dt_bias; bf16* TP; float* VEC;
};
constexpr int PL_RAW = 0, PL_KS = 51200, PL_KK = 67584, PL_LAB = 133120;

__device__ __forceinline__ void prep_unit(const PrepCtx& C, LAS unsigned char* lds, int b, int h, int g) {
    const int tid = tidx(), lane = tid & 63, wid = __builtin_amdgcn_readfirstlane(tid >> 6);
    const int pm = (g == 0) ? 64 + b : b * 8 + (g - 1);
    const size_t row0 = (size_t)pm * 256;
    const bool has_prev = g >= 2, has_next = (g >= 1 && g <= 7);
    LAS bf16* RAW = (LAS bf16*)(lds + PL_RAW);
    LAS float* KK = (LAS float*)(lds + PL_KK);
    LAS float* LBETA = (LAS float*)(lds + PL_LAB); LAS float* LLA = LBETA + 512;
    { const int d = tid >> 8, tl = tid & 255; const float* dr = C.DBDA + (row0 + tl) * 32;
      const float db = dr[d * 8 + h], da = dr[16 + d * 8 + h];
      const float x = da + C.dt_bias[d * 8 + h]; const float sp = x > 15.f ? x : log1pf(__expf(x));
      LBETA[d * 256 + tl] = sigmoidf_(db); LLA[d * 256 + tl] = -__expf(C.a_log[d * 8 + h]) * sp; }
    const int cg = tid & 15, tt0 = tid >> 4;
    for (int j = 0; j < 4; ++j) {
        for (int idx = tid; idx < 66 * 48; idx += 512) {
            const int s = idx / 48, c16 = idx - s * 48; if (j > 0 && s < 2) continue;
            const int tl = 64 * j - 1 + s; const int p = c16 >> 4, cgi = c16 & 15; const int ch = p * 1024 + h * 128 + cgi * 8;
            v4u val = {0u, 0u, 0u, 0u};
            if (tl < 0) { if (has_prev) val = *(const v4u*)(C.HALO + ((size_t)(pm - 1) * 2 + 1) * 3072 + ch); }
            else if (tl > 255) { if (has_next) val = *(const v4u*)(C.HALO + ((size_t)(pm + 1) * 2 + 0) * 3072 + ch); }
            else val = *(const v4u*)(C.QKV + (row0 + tl) * 3072 + ch);
            *(LAS v4u*)(RAW + s * 384 + c16 * 8) = val;
        }
        __syncthreads();
#pragma unroll
        for (int p = 0; p < 3; ++p) {
            const int ch = p * 1024 + h * 128 + cg * 8;
            float cw[3][8];
#pragma unroll
            for (int tp = 0; tp < 3; ++tp) { const f32x4 a = *(const f32x4*)(C.convw + tp * 3072 + ch), bq = *(const f32x4*)(C.convw + tp * 3072 + ch + 4);
#pragma unroll
                for (int e = 0; e < 4; ++e) { cw[tp][e] = a[e]; cw[tp][4 + e] = bq[e]; } }
#pragma unroll
            for (int jj = 0; jj < 2; ++jj) {
                const int tt = tt0 + 32 * jj; float y[8];
#pragma unroll
                for (int e = 0; e < 8; ++e) y[e] = 0.f;
#pragma unroll
                for (int tp = 0; tp < 3; ++tp) { const v4u raw = *(const LAS v4u*)(RAW + (tt + tp) * 384 + p * 128 + cg * 8);
#pragma unroll
                    for (int e = 0; e < 4; ++e) { y[2 * e] += cw[tp][2 * e] * bflo(raw[e]); y[2 * e + 1] += cw[tp][2 * e + 1] * bfhi(raw[e]); } }
#pragma unroll
                for (int e = 0; e < 8; ++e) y[e] = siluf_(y[e]);
                bf16* grow = C.QKV + (row0 + 64 * j + tt) * 3072;
                if (p < 2) {
                    float ss = 0.f;
#pragma unroll
                    for (int e = 0; e < 8; ++e) ss += y[e] * y[e];
                    ss += __shfl_xor(ss, 1); ss += __shfl_xor(ss, 2); ss += __shfl_xor(ss, 4); ss += __shfl_xor(ss, 8);
                    float rn = 1.0f / sqrtf(ss + NORM_EPS); if (p == 0) rn *= 0.088388347648318440f;
                    v2u q0 = {pk2(y[0] * rn, y[1] * rn), pk2(y[2] * rn, y[3] * rn)}, q1 = {pk2(y[4] * rn, y[5] * rn), pk2(y[6] * rn, y[7] * rn)};
                    const int pos0 = 16 * (cg >> 1) + 4 * (cg & 1);
                    bf16* dst = grow + p * 1024 + h * 128 + pos0;
                    *(v2u*)dst = q0; *(v2u*)(dst + 8) = q1;
                    if (p == 1) { LAS unsigned char* ks = lds + PL_KS;
                        *(LAS v2u*)(ks + off_b(tt, 2 * (cg >> 1)) + 8 * (cg & 1)) = q0; *(LAS v2u*)(ks + off_b(tt, 2 * (cg >> 1) + 1) + 8 * (cg & 1)) = q1; }
                } else {
                    v4u w = {pk2(y[0], y[1]), pk2(y[2], y[3]), pk2(y[4], y[5]), pk2(y[6], y[7])};
                    *(v4u*)(grow + 2048 + h * 128 + cg * 8) = w;
                }
            }
        }
        __syncthreads();
        if (wid < 4) {
            const int mt = wid >> 1, nt = wid & 1, r = lane & 31, hh = lane >> 5; LAS unsigned char* ksb = lds + PL_KS;
            f32x16 acc = {};
#pragma unroll
            for (int sg = 0; sg < 8; ++sg) { const bf16x8 a = lda16(ksb + off_b(32 * mt + r, 2 * sg + hh)), bb = lda16(ksb + off_b(32 * nt + r, 2 * sg + hh));
                acc = __builtin_amdgcn_mfma_f32_32x32x16_bf16(a, bb, acc, 0, 0, 0); }
#pragma unroll
            for (int rho = 0; rho < 16; ++rho) KK[(j * 64 + 32 * mt + crow(rho, hh)) * 64 + 32 * nt + r] = acc[rho];
        } else if (tid - 256 < 96 && j < 3) {
            const int i2 = tid - 256; const int s = i2 / 48, c16 = i2 - s * 48;
            const v4u val = *(const LAS v4u*)(RAW + (64 + s) * 384 + c16 * 8); *(LAS v4u*)(RAW + s * 384 + c16 * 8) = val;
        }
        __syncthreads();
    }
    {
        const int jw = wid >> 1, dir = wid & 1;
        const float beta = LBETA[dir * 256 + 64 * jw + lane], la = LLA[dir * 256 + 64 * jw + lane];
        float gam = la;
#pragma unroll
        for (int o = 1; o < 64; o <<= 1) { const float up = __shfl_up(gam, o), dn = __shfl_down(gam, o); if (dir == 0) { if (lane >= o) gam += up; } else { if (lane + o < 64) gam += dn; } }
        const float rsv = dir == 0 ? beta : 1.f, csv = dir == 0 ? 1.f : beta;
        float W[64];
        const LAS float* kkb = KK + jw * 4096;
#pragma unroll
        for (int i = 0; i < 64; ++i) {
            float s = 0.f;
#pragma unroll
            for (int q4 = 0; q4 < (i + 3) / 4; ++q4) { const f32x4 kv = *(const LAS f32x4*)(kkb + i * 64 + 4 * q4);
#pragma unroll
                for (int e = 0; e < 4; ++e) if (4 * q4 + e < i) s += kv[e] * W[4 * q4 + e]; }
            const float rs_i = readlane_f(rsv, i), cs_i = readlane_f(csv, i);
            const float yv = (lane == i ? 1.f : 0.f) - rs_i * s;
            W[i] = cs_i * yv;
        }
        const int cidx = (g == 0) ? jw : 4 * g + jw;
        const size_t cd = ((size_t)(b * 8 + h) * NCH + cidx) * 2 + dir;
        bf16* tp = C.TP + cd * 4096; float* vec = C.VEC + cd * 256;
        if (dir == 0) {
            const int pc = swz16(lane & 15) + (lane & 48);
#pragma unroll
            for (int i = 0; i < 64; ++i) { const float gi = readlane_f(gam, i);
                const float val = (i >= lane) ? fast_exp(fminf(gi - gam, 0.f)) * W[i] * beta : 0.f;
                tp[i * 64 + pc] = (bf16)f2bf(val); }
        } else {
            float vals[64];
#pragma unroll
            for (int i = 0; i < 64; ++i) { const float gi = readlane_f(gam, i); vals[i] = (i >= lane) ? fast_exp(fminf(gam - gi, 0.f)) * W[i] : 0.f; }
#pragma unroll
            for (int k8 = 0; k8 < 8; ++k8) { v4u w;
#pragma unroll
                for (int e = 0; e < 4; ++e) { const int p0 = 8 * k8 + 2 * e, p1 = p0 + 1; w[e] = pk2(vals[(p0 & 48) + swz16(p0 & 15)], vals[(p1 & 48) + swz16(p1 & 15)]); }
                *(v4u*)(tp + lane * 64 + 8 * k8) = w; }
        }
        const float gl0 = readlane_f(gam, 63), gl1 = readlane_f(gam, 0); const float gl = dir == 0 ? gl0 : gl1;
        vec[lane] = fast_exp(gam); vec[64 + lane] = fast_exp(gl - gam); vec[128 + lane] = gam; if (lane == 0) vec[192] = fast_exp(gl);
    }
    __syncthreads();
}

struct ScanCtx { const bf16* QKV; const bf16* TP; const float* VEC; bf16* O0; bf16* O1; };
constexpr int SB_KQ = 0, SB_TP = 32768, SB_P = 40960, SB_V = 49152, SB_STRIDE = 65536, SL_VEC = 131072;

__device__ __forceinline__ int scan_cidx(int dir, int n) { return dir == 0 ? n : (n < 4 ? 3 - n : 39 - n); }

__device__ __forceinline__ void scan_fill(const ScanCtx& C, LAS unsigned char* lds, int b, int h, int dir, int cidx, int buf) {
    const int ht = tidx() - 256, lane = ht & 63, hw = __builtin_amdgcn_readfirstlane(ht >> 6);
    const bool has_out = cidx >= 4;
    const size_t row0 = cidx < 4 ? (size_t)M_LAT + b * 256 + 64 * cidx : (size_t)b * 2048 + 64 * (cidx - 4);
    const size_t cd = ((size_t)(b * 8 + h) * NCH + cidx) * 2 + dir;
    LAS unsigned char* B = lds + buf * SB_STRIDE;
    const bf16* qkv = C.QKV + row0 * 3072 + h * 128;
    v4u kq[8], tpv[2], vv[4]; v4u vecv = {0u, 0u, 0u, 0u};
#pragma unroll
    for (int i = 0; i < 8; ++i) { const int idx = ht + 256 * i, row = idx >> 4, ch = idx & 15;
        if (row < 64) kq[i] = *(const v4u*)(qkv + (size_t)row * 3072 + 1024 + ch * 8);
        else if (has_out) kq[i] = *(const v4u*)(qkv + (size_t)(row - 64) * 3072 + ch * 8);
        else kq[i] = (v4u){0u, 0u, 0u, 0u}; }
#pragma unroll
    for (int i = 0; i < 2; ++i) { const int idx = ht + 256 * i; tpv[i] = *(const v4u*)(C.TP + cd * 4096 + (size_t)idx * 8); }
#pragma unroll
    for (int i = 0; i < 4; ++i) { const int idx = ht + 256 * i, row = idx >> 4, ch = idx & 15; vv[i] = *(const v4u*)(qkv + (size_t)row * 3072 + 2048 + ch * 8); }
    if (ht < 64) vecv = *(const v4u*)(C.VEC + cd * 256 + ht * 4);
    const int r = lane & 31, hh = lane >> 5;
    int mt = 0, nt = 0; if (hw == 1) { mt = dir == 0 ? 1 : 0; nt = dir == 0 ? 0 : 1; } else if (hw == 2) { mt = 1; nt = 1; }
    const bool do_p = has_out && hw < 3;
    f32x16 acc = {};
    if (do_p) {
        bf16x8 kf[8], qf[8];
#pragma unroll
        for (int sg = 0; sg < 8; ++sg) { kf[sg] = *(const bf16x8*)(qkv + (size_t)(32 * nt + r) * 3072 + 1024 + 16 * sg + 8 * hh); qf[sg] = *(const bf16x8*)(qkv + (size_t)(32 * mt + r) * 3072 + 16 * sg + 8 * hh); }
#pragma unroll
        for (int sg = 0; sg < 8; ++sg) acc = __builtin_amdgcn_mfma_f32_32x32x16_bf16(kf[sg], qf[sg], acc, 0, 0, 0);
    }
#pragma unroll
    for (int i = 0; i < 8; ++i) { const int idx = ht + 256 * i, row = idx >> 4, ch = idx & 15; *(LAS v4u*)(B + SB_KQ + off_b(row, ch)) = kq[i]; }
#pragma unroll
    for (int i = 0; i < 2; ++i) { const int idx = ht + 256 * i, row = idx >> 3, ch = idx & 7; *(LAS v4u*)(B + SB_TP + off_t(row, ch)) = tpv[i]; }
#pragma unroll
    for (int i = 0; i < 4; ++i) { const int idx = ht + 256 * i, row = idx >> 4, ch = idx & 15; *(LAS v4u*)(B + SB_V + off_b(row, ch)) = vv[i]; }
    if (ht < 64) *(LAS v4u*)(lds + SL_VEC + buf * 1024 + ht * 16) = vecv;
    if (do_p) {
        const float* gv = C.VEC + cd * 256 + 128;
        const int a = 32 * mt + r; const float ga = gv[a];
        float val[16];
#pragma unroll
        for (int g4 = 0; g4 < 4; ++g4) { const f32x4 gb = *(const f32x4*)(gv + 32 * nt + 8 * g4 + 4 * hh);
#pragma unroll
            for (int e = 0; e < 4; ++e) { const int bb = 32 * nt + 8 * g4 + 4 * hh + e; const bool ok = dir == 0 ? (bb <= a) : (bb >= a);
                val[4 * g4 + e] = ok ? fast_exp(fminf(ga - gb[e], 0.f)) * acc[4 * g4 + e] : 0.f; } }
#pragma unroll
        for (int s = 0; s < 2; ++s) { v4u w = {cvtpk(val[8 * s], val[8 * s + 1]), cvtpk(val[8 * s + 2], val[8 * s + 3]), cvtpk(val[8 * s + 4], val[8 * s + 5]), cvtpk(val[8 * s + 6], val[8 * s + 7])};
            *(LAS v4u*)(B + SB_P + off_t(a, 4 * nt + 2 * s + hh)) = w; }
    }
}

#define GDN_PACK8(X, base) ((v4u){cvtpk(X[(base)], X[(base) + 1]), cvtpk(X[(base) + 2], X[(base) + 3]), cvtpk(X[(base) + 4], X[(base) + 5]), cvtpk(X[(base) + 6], X[(base) + 7])})

__device__ __forceinline__ void scan_step(const ScanCtx& C, LAS unsigned char* lds, int b, int h, int dir, int cidx, int buf, f32x16 (&Sacc)[4], v4u (&SBp)[4][2]) {
    const int lane = tidx() & 63, w = __builtin_amdgcn_readfirstlane(tidx() >> 6);
    const int r = lane & 31, hh = lane >> 5, blk = (lane >> 4) & 1, q4 = (lane & 15) >> 2, p4 = lane & 3;
    const bool has_out = cidx >= 4;
    LAS unsigned char* B = lds + buf * SB_STRIDE;
    const LAS float* vec = (const LAS float*)(lds + SL_VEC + buf * 1024);
    v4u RB[4];
#pragma unroll
    for (int mt = 0; mt < 2; ++mt) { f32x16 acc = {};
#pragma unroll
        for (int t = 0; t < 4; ++t)
#pragma unroll
            for (int s = 0; s < 2; ++s) acc = __builtin_amdgcn_mfma_f32_32x32x16_bf16(lda16(B + SB_KQ + off_b(32 * mt + r, 4 * t + 2 * s + hh)), __builtin_bit_cast(bf16x8, SBp[t][s]), acc, 0, 0, 0);
        float rr[16];
#pragma unroll
        for (int g4 = 0; g4 < 4; ++g4) { const int tb = 32 * mt + 8 * g4 + 4 * hh;
            const s16x4 v4 = vtr(B + SB_V + off_b(tb + q4, 4 * w + 2 * blk + (p4 >> 1)) + 8 * (p4 & 1));
            const f32x4 eg = *(const LAS f32x4*)(vec + tb);
#pragma unroll
            for (int e = 0; e < 4; ++e) rr[4 * g4 + e] = bf2f((unsigned short)v4[e]) - eg[e] * acc[4 * g4 + e]; }
        RB[2 * mt] = GDN_PACK8(rr, 0); RB[2 * mt + 1] = GDN_PACK8(rr, 8); }
    f32x16 dl[2];
#pragma unroll
    for (int mt = 0; mt < 2; ++mt) { f32x16 acc = {};
#pragma unroll
        for (int s = 0; s < 4; ++s) acc = __builtin_amdgcn_mfma_f32_32x32x16_bf16(lda16(B + SB_TP + off_t(32 * mt + r, 2 * s + hh)), __builtin_bit_cast(bf16x8, RB[s]), acc, 0, 0, 0);
        dl[mt] = acc; }
    v4u DB[4], D2B[4];
#pragma unroll
    for (int mt = 0; mt < 2; ++mt) { float d2[16], d1[16];
#pragma unroll
        for (int g4 = 0; g4 < 4; ++g4) { const f32x4 egl = *(const LAS f32x4*)(vec + 64 + 32 * mt + 8 * g4 + 4 * hh);
#pragma unroll
            for (int e = 0; e < 4; ++e) { d1[4 * g4 + e] = dl[mt][4 * g4 + e]; d2[4 * g4 + e] = egl[e] * dl[mt][4 * g4 + e]; } }
        DB[2 * mt] = GDN_PACK8(d1, 0); DB[2 * mt + 1] = GDN_PACK8(d1, 8); D2B[2 * mt] = GDN_PACK8(d2, 0); D2B[2 * mt + 1] = GDN_PACK8(d2, 8); }
    if (has_out) {
        const size_t m0 = (size_t)b * 2048 + 64 * (cidx - 4);
#pragma unroll
        for (int mt = 0; mt < 2; ++mt) { f32x16 acc = {};
#pragma unroll
            for (int t = 0; t < 4; ++t)
#pragma unroll
                for (int s = 0; s < 2; ++s) acc = __builtin_amdgcn_mfma_f32_32x32x16_bf16(lda16(B + SB_KQ + off_b(64 + 32 * mt + r, 4 * t + 2 * s + hh)), __builtin_bit_cast(bf16x8, SBp[t][s]), acc, 0, 0, 0);
#pragma unroll
            for (int g4 = 0; g4 < 4; ++g4) { const f32x4 eg = *(const LAS f32x4*)(vec + 32 * mt + 8 * g4 + 4 * hh);
#pragma unroll
                for (int e = 0; e < 4; ++e) acc[4 * g4 + e] *= eg[e]; }
#pragma unroll
            for (int s = 0; s < 4; ++s) acc = __builtin_amdgcn_mfma_f32_32x32x16_bf16(lda16(B + SB_P + off_t(32 * mt + r, 2 * s + hh)), __builtin_bit_cast(bf16x8, DB[s]), acc, 0, 0, 0);
#pragma unroll
            for (int rho = 0; rho < 16; ++rho) { const size_t m = m0 + 32 * mt + crow(rho, hh); const bf16 ov = (bf16)f2bf(acc[rho]);

#ifdef SWAP_O
                if (dir == 1) C.O0[m * 2048 + h * 128 + 32 * w + r] = ov; else C.O1[m * 1024 + h * 128 + 32 * w + r] = ov; }
#else
                if (dir == 0) C.O0[m * 2048 + h * 128 + 32 * w + r] = ov; else C.O1[m * 1024 + h * 128 + 32 * w + r] = ov; }
#endif

        }
    }
    const float glast = vec[192];
#pragma unroll
    for (int t = 0; t < 4; ++t) { f32x16 acc = Sacc[t];
#pragma unroll
        for (int rho = 0; rho < 16; ++rho) acc[rho] *= glast;
#pragma unroll
        for (int s = 0; s < 4; ++s) {
            const int pp = (p4 == 1) ? 2 : (p4 == 2 ? 1 : p4);
            const s16x4 lo = vtr(B + SB_KQ + off_b(16 * s + 4 * hh + q4, 4 * t + 2 * blk + (pp >> 1)) + 8 * (pp & 1));
            const s16x4 hi4 = vtr(B + SB_KQ + off_b(16 * s + 8 + 4 * hh + q4, 4 * t + 2 * blk + (pp >> 1)) + 8 * (pp & 1));
            const bf16x8 a = {lo[0], lo[1], lo[2], lo[3], hi4[0], hi4[1], hi4[2], hi4[3]};
            acc = __builtin_amdgcn_mfma_f32_32x32x16_bf16(a, __builtin_bit_cast(bf16x8, D2B[s]), acc, 0, 0, 0); }
        Sacc[t] = acc;
        SBp[t][0] = GDN_PACK8(acc, 0); SBp[t][1] = GDN_PACK8(acc, 8); }
}
}
constexpr int NWAVES = 8;
#ifndef MK_LAST_PHASE
#define MK_LAST_PHASE 99
#endif
enum { I_X = 0, I_C, I_CTX, I_CCTX, I_WMOD, I_BMOD, I_WIN, I_QNW, I_KNW, I_CONVW, I_ALOG, I_DTB, I_GNW, I_WPA, I_WPD, I_WOUT, I_WUP, I_FCW, I_FCB, I_WDN, I_FNW, N_IN };
struct Args { const float* in[N_IN]; float* out; unsigned char* ws; int ph_lo, ph_hi; };

__device__ __forceinline__ void transpose_item(const float* W, int N, bf16* WT, int ldw, int koff, int drow0, LAS float* scr, int kb, int nb, int lane) {
    const int k0 = 64 * kb, n0 = 32 * nb;
#pragma unroll 8
    for (int i = 0; i < 32; ++i) { const int kk = 2 * i + (lane >> 5); scr[kk * 33 + (lane & 31)] = W[(size_t)(k0 + kk) * N + n0 + (lane & 31)]; }
    LDS_WAIT(); asm volatile("" ::: "memory");
    const int c = lane & 7;
#pragma unroll
    for (int j = 0; j < 4; ++j) { const int n = (lane >> 3) + 8 * j; const LAS float* s = scr + (8 * c) * 33 + n;
        v4u o; o.x = pk2(s[0 * 33], s[1 * 33]); o.y = pk2(s[2 * 33], s[3 * 33]); o.z = pk2(s[4 * 33], s[5 * 33]); o.w = pk2(s[6 * 33], s[7 * 33]);
        *(v4u*)(WT + (size_t)(drow0 + n) * ldw + koff + k0 + 8 * c) = o; }
    LDS_WAIT(); asm volatile("" ::: "memory");
}
__device__ __forceinline__ void rms_row(const float* xrow, int lane, f32x4 (&v)[4], float& rstd) {
    const f32x4* xr = (const f32x4*)xrow + lane; float s = 0.f;
#pragma unroll
    for (int j = 0; j < 4; ++j) { v[j] = xr[64 * j]; s += (v[j].x * v[j].x + v[j].y * v[j].y) + (v[j].z * v[j].z + v[j].w * v[j].w); }
    rstd = 1.0f / sqrtf(wave_sum(s) * (1.0f / 1024.0f) + NORM_EPS);
}
__device__ __forceinline__ void norm_mod_row_bf16(const float* xrow, const float* shift, const float* scale, bf16* orow, int lane) {
    f32x4 v[4]; float rstd; rms_row(xrow, lane, v, rstd);
    unsigned long long* o8 = (unsigned long long*)orow + lane;
#pragma unroll
    for (int j = 0; j < 4; ++j) { const f32x4 sh = ((const f32x4*)shift)[lane + 64 * j], sc = ((const f32x4*)scale)[lane + 64 * j];
        const float a = v[j].x * rstd * (1.f + sc.x) + sh.x, b = v[j].y * rstd * (1.f + sc.y) + sh.y, c = v[j].z * rstd * (1.f + sc.z) + sh.z, d = v[j].w * rstd * (1.f + sc.w) + sh.w;
        o8[64 * j] = (unsigned long long)pk2(a, b) | ((unsigned long long)pk2(c, d) << 32); }
}

template <class F> struct EpiRow8 {
    static constexpr bool PERM = true, AFTER_DRAIN = false; F f;
    __device__ __forceinline__ void operator()(const f32x4 (&acc)[2][2][4][2], const pg8::Unit& u, int wr, int wc, int fr, int fq) const {
#pragma unroll
        for (int ai = 0; ai < 2; ++ai)
#pragma unroll
            for (int m = 0; m < 4; ++m) { const int rt = ai * 128 + wr * 64 + m * 16 + fr;
#pragma unroll
                for (int bj = 0; bj < 2; ++bj) f(u, rt, bj * 128 + wc * 32 + 8 * fq, acc[ai][bj][m][0], acc[ai][bj][m][1]); }
    }
};
__device__ __forceinline__ v4u pack8(f32x4 a, f32x4 b) { return (v4u){cvtpk(a[0], a[1]), cvtpk(a[2], a[3]), cvtpk(b[0], b[1]), cvtpk(b[2], b[3])}; }
__device__ __forceinline__ void unpack8(v4u w, f32x4& a, f32x4& b) { a = (f32x4){bflo(w[0]), bfhi(w[0]), bflo(w[1]), bfhi(w[1])}; b = (f32x4){bflo(w[2]), bfhi(w[2]), bflo(w[3]), bfhi(w[3])}; }

struct InProjF { bf16 *K, *V, *QKV, *HALO, *A2; float* DBDA;
    __device__ __forceinline__ void operator()(const pg8::Unit& u, int rt, int ct, f32x4 v0, f32x4 v1) const {
        const int pn = u.pn; const size_t row = (size_t)u.pm * 256 + rt;
        if (pn == 18) { if (ct < 32) { float* d = DBDA + row * 32 + ct; *(f32x4*)d = v0; *(f32x4*)(d + 4) = v1; } return; }
        const v4u w = pack8(v0, v1);
        if (pn < 2) { const size_t kvrow = u.pm < 64 ? (size_t)(u.pm >> 3) * KVLEN + CTXL + (u.pm & 7) * 256 + rt : (size_t)(u.pm - 64) * KVLEN + rt;
            *(v4u*)((pn == 0 ? K : V) + kvrow * 256 + ct) = w; }
        else if (pn < 14) { const int c = (pn - 2) * 256 + ct; *(v4u*)(QKV + row * 3072 + c) = w;
            if (rt == 0 || rt == 255) *(v4u*)(HALO + ((size_t)u.pm * 2 + (rt == 255 ? 1 : 0)) * 3072 + c) = w; }
        else *(v4u*)(A2 + row * 2048 + (pn - 14) * 256 + ct) = w;
    }
};
struct P2Order {
    pg8::StaticOrder so; int G, c;
    __device__ __forceinline__ void init(int G_, int c_) { so.init(64, WIN_P2_TILES, G_, c_); G = G_; c = c_; }
    __device__ __forceinline__ bool next(int i, pg8::Unit& u) const {
        const int L = i * G + c; if (L < 64 * WIN_P2_TILES) return so.next(i, u);
        const int j = L - 64 * WIN_P2_TILES; if (j >= 8 * 15) return false;
        u.pm = 64 + (j & 7); const int q = j >> 3; u.pn = q < 14 ? q : 18; return true; }
    __device__ __forceinline__ void a_ready(const pg8::Unit&) const {}
    __device__ __forceinline__ void done(const pg8::Unit&) const {}
};
struct GateF { bf16 *ZS, *GATES;
    __device__ __forceinline__ void operator()(const pg8::Unit& u, int rt, int ct, f32x4 v0, f32x4 v1) const {
        const size_t row = (size_t)u.pm * 256 + rt;
#pragma unroll
        for (int e = 0; e < 4; ++e) { if (u.pn < 4) { v0[e] = siluf_(v0[e]); v1[e] = siluf_(v1[e]); } else { v0[e] = sigmoidf_(v0[e]); v1[e] = sigmoidf_(v1[e]); } }
        const v4u w = pack8(v0, v1);
        if (u.pn < 4) *(v4u*)(ZS + row * 1024 + u.pn * 256 + ct) = w; else *(v4u*)(GATES + row * 2048 + (u.pn - 4) * 256 + ct) = w;
    }
};
struct Merge1F { const bf16* GATES; bf16* Y1;
    __device__ __forceinline__ void operator()(const pg8::Unit& u, int rt, int ct, f32x4 v0, f32x4 v1) const {
        const size_t row = (size_t)u.pm * 256 + rt; const int col = u.pn * 256 + ct;
        f32x4 g0, g1; unpack8(*(const v4u*)(GATES + row * 2048 + col), g0, g1);
        *(v4u*)(Y1 + row * 1024 + col) = pack8(v0 * g0, v1 * g1); }
};
struct Merge2F { const bf16* GATES; const bf16* Y1; bf16* Y;
    __device__ __forceinline__ void operator()(const pg8::Unit& u, int rt, int ct, f32x4 v0, f32x4 v1) const {
        const size_t row = (size_t)u.pm * 256 + rt; const int col = u.pn * 256 + ct;
        f32x4 g0, g1, a0, a1; unpack8(*(const v4u*)(GATES + row * 2048 + 1024 + col), g0, g1); unpack8(*(const v4u*)(Y1 + row * 1024 + col), a0, a1);

#ifdef ZERO_GDN
        v0 = v0 * 0.f; v1 = v1 * 0.f;
#endif
#ifdef ZERO_ATTN
        a0 = a0 * 0.f; a1 = a1 * 0.f;
#endif
        *(v4u*)(Y + row * 1024 + col) = pack8(a0 + v0 * g0, a1 + v1 * g1); }
};
struct ResidF { const float* base; const float* mod; int goff; float* out;
    __device__ __forceinline__ void operator()(const pg8::Unit& u, int rt, int ct, f32x4 v0, f32x4 v1) const {
        const size_t row = (size_t)u.pm * 256 + rt; const int col = u.pn * 256 + ct; const int b = u.pm >> 3;
        const float* g = mod + (size_t)b * 6144 + goff + col; const f32x4 g0 = *(const f32x4*)g, g1 = *(const f32x4*)(g + 4);
        const float* bp = base + row * 1024 + col; const f32x4 b0 = *(const f32x4*)bp, b1 = *(const f32x4*)(bp + 4);
        float* o = out + row * 1024 + col; *(f32x4*)o = b0 + g0 * v0; *(f32x4*)(o + 4) = b1 + g1 * v1; }
};
struct UpF { bf16* U;
    __device__ __forceinline__ void operator()(const pg8::Unit& u, int rt, int ct, f32x4 v0, f32x4 v1) const {
        const size_t row = (size_t)u.pm * 256 + rt; *(v4u*)(U + row * 3072 + u.pn * 256 + ct) = pack8(v0, v1); }
};

#define GRID_BAR() xcd_barrier(bar)
__global__ void __launch_bounds__(NWAVES * 64, 2) fwd_kernel(Args args) {
    extern __shared__ __attribute__((aligned(16))) unsigned char lds_raw[];
    LAS unsigned char* lds = (LAS unsigned char*)lds_raw;
    volatile LAS unsigned* MISC = (volatile LAS unsigned*)(lds + MISC_OFF);
    const int tid0 = tidx(), wave = __builtin_amdgcn_readfirstlane(tid0 >> 6);
#define PH_LOCALS const int tid = tidx(), lane = tid & 63; (void)lane; (void)tid
    const int G = gridDim.x, bx = blockIdx.x;
    const int vcu = (G % 8 == 0) ? (bx % 8) * (G / 8) + bx / 8 : bx;
    const int gw = vcu * NWAVES + wave, NGW = G * NWAVES;
    unsigned char* ws = args.ws; unsigned char* dob = (unsigned char*)args.out;
    gu32* ctl = (gu32*)(ws + WS_CTL);
    const float* x = args.in[I_X];
    float* MOD = (float*)(ws + WS_MOD); float* ROPE = (float*)(ws + WS_ROPE);
    bf16* HALO = (bf16*)(ws + WS_HALO); float* DBDA = (float*)(ws + WS_DBDA);
    bf16* WinT = (bf16*)(ws + WS_WIN); bf16* KB = (bf16*)(ws + WS_K); bf16* VB = (bf16*)(ws + WS_V);
    bf16* A2 = (bf16*)(ws + WS_A2); bf16* QKV = (bf16*)(ws + WS_QKV); bf16* TP = (bf16*)(ws + WS_TP); float* VEC = (float*)(ws + WS_VEC);
    bf16* ZS = (bf16*)(ws + WS_ZS); bf16* GATES = (bf16*)(ws + WS_GATES);
    bf16* WmT = (bf16*)(ws + WS_WM); bf16* WoT = (bf16*)(ws + WS_WO); bf16* WupT = (bf16*)(ws + WS_WUP); bf16* WdT = (bf16*)(ws + WS_WDN);
    bf16* Y = (bf16*)(ws + WS_Y); bf16* H2 = (bf16*)(ws + WS_H2); bf16* ACT = (bf16*)(ws + WS_ACT); bf16* UR = (bf16*)(ws + WS_U);
    bf16* XN = (bf16*)(dob + DO_XN); bf16* O1 = (bf16*)(dob + DO_O1); bf16* Y1 = (bf16*)dob; float* X1 = (float*)dob;

    for (int u = tid0; u < (LDS_BYTES - LDSCTL_OFF) / 4; u += NWAVES * 64) ((LAS unsigned*)(lds + LDSCTL_OFF))[u] = 0u;
    __syncthreads();
    XcdBarrier bar = xcd_barrier_post((unsigned*)(ctl + CW_BAR), MISC + 8);
    const int lo = args.ph_lo, hi = args.ph_hi;
#ifndef PH_MASK
#define PH_MASK 0x1ffff
#endif
#define IN(k) ((((PH_MASK) >> (k)) & 1) && lo <= (k) && (k) < hi)
#define SEAM(k) do { if (IN(k) && IN((k) + 1)) GRID_BAR(); DUMP_CHECK(k); } while (0)
#ifdef DUMP_PHASE
#define DUMP_CHECK(k) do { if ((k) == DUMP_PHASE) { float* dst = args.out; \
      GRID_BAR(); for (long i = (long)vcu * 512 + tid0; i < (long)M_LAT * 1024; i += (long)G * 512) { dst[i] = DUMP_EXPR(i); } return; } } while (0)
#else
#define DUMP_CHECK(k) do {} while (0)
#endif

    if (IN(0)) { PH_LOCALS;
        if (bx < 192) {
            LAS float* sc = (LAS float*)lds; LAS float* part = (LAS float*)(lds + 40960);
            for (int i = tid; i < 9 * 1024; i += 512) { const int r = i >> 10, k = i & 1023; const float v = r < 8 ? args.in[I_C][r * 1024 + k] : args.in[I_CCTX][k]; sc[i] = siluf_(v); }
            __syncthreads();
            for (int item = bx; item < 192; item += G) {
                const int n0 = item * 32, col = lane & 31, kh = lane >> 5, kbase = wave * 128 + kh * 64;
                float acc[9];
#pragma unroll
                for (int r = 0; r < 9; ++r) acc[r] = 0.f;
                const float* wp = args.in[I_WMOD] + (size_t)kbase * 6144 + n0 + col;
#pragma unroll 8
                for (int kk = 0; kk < 64; ++kk) { const float w = wp[(size_t)kk * 6144];
#pragma unroll
                    for (int r = 0; r < 9; ++r) acc[r] += sc[r * 1024 + kbase + kk] * w; }
#pragma unroll
                for (int r = 0; r < 9; ++r) part[((wave * 2 + kh) * 9 + r) * 32 + col] = acc[r];
                __syncthreads();
                if (tid < 288) { const int r = tid >> 5, c2 = tid & 31; float s = args.in[I_BMOD][n0 + c2];
#pragma unroll
                    for (int p = 0; p < 16; ++p) s += part[(p * 9 + r) * 32 + c2];
                    MOD[r * 6144 + n0 + c2] = s; }
                __syncthreads();
            }
        }
        __syncthreads();
        {
            LAS float* scr = (LAS float*)(lds + wave * 16384);
            for (int it = gw; it < 16 * 241; it += NGW) { const int kb = it / 241, nb = it - kb * 241; const int n0 = nb * 32;
                const int drow = n0 < 3584 ? n0 : (n0 < 3616 ? 4608 + (n0 - 3584) : (n0 < 4640 ? 3584 + (n0 - 3616) : 4864 + (n0 - 4640)));
                transpose_item(args.in[I_WIN], 7712, WinT, 1024, 0, drow, scr, kb, nb, lane); }
            const int gt = vcu * 512 + tid;
            for (int i = gt; i < 224 * 128; i += G * 512) *(v4u*)(WinT + (size_t)4640 * 1024 + (size_t)i * 8) = (v4u){0u, 0u, 0u, 0u};
            for (int i = gt; i < 64 * 32; i += G * 512) { const int pos = i >> 5, f = i & 31;
                const float invf = exp2f(-(float)f * (13.287712379549449f / 32.0f)); const float ang = (float)pos * invf;
                float sn, cs; sincosf(ang, &sn, &cs); ROPE[2 * i] = cs; ROPE[2 * i + 1] = sn; }
        }
    }
    SEAM(0);
    if (IN(1)) { PH_LOCALS;
        for (int m = gw; m < M_ALL; m += NGW) {
            const float* xr = m < M_LAT ? x + (size_t)m * 1024 : args.in[I_CTX] + (size_t)(m - M_LAT) * 1024;
            const int r = m < M_LAT ? (m >> 11) : 8;
            norm_mod_row_bf16(xr, MOD + r * 6144, MOD + r * 6144 + 1024, XN + (size_t)m * 1024, lane);
        }
    }
    SEAM(1);
    if (IN(2)) { PH_LOCALS;
        pg8::Gemm g{XN, WinT, 1024, 1024, 1024}; P2Order S; S.init(G, bx);
        EpiRow8<InProjF> E{InProjF{KB, VB, QKV, HALO, A2, DBDA}};
        pg8::gemm_phase<EpiRow8<InProjF>, P2Order, true, true>(lds, g, S, E);
    }
    SEAM(2);
    if (IN(3)) { PH_LOCALS;
        const float* knw = args.in[I_KNW];
        for (int kr = gw; kr < NB * KVLEN; kr += NGW) {
            const int b = kr / KVLEN, s = kr - b * KVLEN; const int head = lane >> 5, li = lane & 31;
            bf16* p = KB + (size_t)kr * 256 + head * 128 + 4 * li;
            const v2u raw = *(const v2u*)p; float v[4] = {bflo(raw.x), bfhi(raw.x), bflo(raw.y), bfhi(raw.y)};
            float ss = v[0] * v[0] + v[1] * v[1] + v[2] * v[2] + v[3] * v[3];
            ss += __shfl_xor(ss, 1); ss += __shfl_xor(ss, 2); ss += __shfl_xor(ss, 4); ss += __shfl_xor(ss, 8); ss += __shfl_xor(ss, 16);
            const float rstd = 1.0f / sqrtf(ss * (1.0f / 128.0f) + NORM_EPS); const f32x4 wv = *(const f32x4*)(knw + 4 * li);
#pragma unroll
            for (int e = 0; e < 4; ++e) v[e] *= rstd * wv[e];
            float pv[4];
#pragma unroll
            for (int e = 0; e < 4; ++e) pv[e] = __shfl_xor(v[e], 8);
            if (s >= CTXL) { const int t = s - CTXL, ax = li >> 4, pos = ax ? (t & 63) : (t >> 6); const bool x2 = (li & 8) != 0;
                const float* tb = ROPE + pos * 64 + 8 * (li & 7); const f32x4 c0 = *(const f32x4*)tb, c1 = *(const f32x4*)(tb + 4);
                const float cs[4] = {c0.x, c0.z, c1.x, c1.z}, sn[4] = {c0.y, c0.w, c1.y, c1.w};
#pragma unroll
                for (int e = 0; e < 4; ++e) v[e] = x2 ? v[e] * cs[e] + pv[e] * sn[e] : v[e] * cs[e] - pv[e] * sn[e]; }
            *(v2u*)p = (v2u){pk2(v[0], v[1]), pk2(v[2], v[3])};
        }
        gdn::PrepCtx PC{QKV, HALO, DBDA, args.in[I_CONVW], args.in[I_ALOG], args.in[I_DTB], TP, VEC};
        for (int u = vcu; u < NB * 8 * 9; u += G) { const int b = u / 72, rem = u - b * 72, h = rem / 9, g = rem - h * 9; gdn::prep_unit(PC, lds, b, h, g); }
    }
    SEAM(3);
    if (IN(4)) { PH_LOCALS;
#ifndef NO_SCAN
        if (bx < 128) {
            const int b = bx >> 4, h = (bx >> 1) & 7, dir = bx & 1;
            gdn::ScanCtx SC{QKV, TP, VEC, A2 + 1024, O1};
            for (int i = tid; i < 2 * 8192 / 16; i += 512) { const int bufi = i >> 9, o = i & 511; *(LAS v4u*)(lds + bufi * gdn::SB_STRIDE + gdn::SB_P + o * 16) = (v4u){0u, 0u, 0u, 0u}; }
            __syncthreads();
            if (wave >= 4) {
                gdn::scan_fill(SC, lds, b, h, dir, gdn::scan_cidx(dir, 0), 0);
                LDS_WAIT(); __syncthreads();
#pragma unroll 1
                for (int n = 0; n < NCH; ++n) { if (n + 1 < NCH) gdn::scan_fill(SC, lds, b, h, dir, gdn::scan_cidx(dir, n + 1), (n + 1) & 1); LDS_WAIT(); __syncthreads(); }
            } else {
                f32x16 Sacc[4]; v4u SBp[4][2];
#pragma unroll
                for (int t = 0; t < 4; ++t) { Sacc[t] = f32x16{}; SBp[t][0] = (v4u){0u, 0u, 0u, 0u}; SBp[t][1] = (v4u){0u, 0u, 0u, 0u}; }
                __syncthreads();
#pragma unroll 1
                for (int n = 0; n < NCH; ++n) { gdn::scan_step(SC, lds, b, h, dir, gdn::scan_cidx(dir, n), n & 1, Sacc, SBp); LDS_WAIT(); __syncthreads(); }
            }
            VM_WAIT();
        }
#endif
        __syncthreads();
#ifndef NO_ATTN
        for (;;) {
            if (tid == 0) MISC[16] = atomicAdd((unsigned*)(ctl + CW_QUEUE), 1u);
            __syncthreads(); const unsigned u = MISC[16]; __syncthreads();
            if (u >= 512u) break;
            const int b = u >> 6, rem = u & 63, kvh = rem >> 5, hq = (rem >> 3) & 3, h = kvh * 4 + hq, qb = rem & 7;
            att::attn_unit(A2 + ((size_t)b * SEQ + qb * 256) * 2048 + h * 128, KB + (size_t)b * KVLEN * 256 + kvh * 128, VB + (size_t)b * KVLEN * 256 + kvh * 128,
                           qb * 256, args.in[I_QNW], ROPE, KVLEN, (char*)lds_raw);
        }
#endif
    }
    SEAM(4);
    if (IN(5)) { PH_LOCALS;
        pg8::Gemm g{XN, WinT + (size_t)WIN_G_ROW0 * 1024, 1024, 1024, 1024}; pg8::StaticOrder S; S.init(64, 12, G, bx);
        EpiRow8<GateF> E{GateF{ZS, GATES}};
        pg8::gemm_phase<EpiRow8<GateF>, pg8::StaticOrder, true, true>(lds, g, S, E);
    }
    SEAM(5);
    if (IN(6)) { PH_LOCALS;
        const float* gnw = args.in[I_GNW];
        for (int m = gw; m < M_LAT; m += NGW) {
            bf16* p0 = A2 + (size_t)m * 2048 + 1024 + lane * 16; const bf16* p1 = O1 + (size_t)m * 1024 + lane * 16; const bf16* pz = ZS + (size_t)m * 1024 + lane * 16;
            float s[16]; float ss = 0.f;
#pragma unroll
            for (int q = 0; q < 2; ++q) { f32x4 a0, a1, b0, b1; unpack8(*(const v4u*)(p0 + 8 * q), a0, a1); unpack8(*(const v4u*)(p1 + 8 * q), b0, b1);
#pragma unroll
                for (int e = 0; e < 4; ++e) {
#ifdef ZERO_O1
                    b0[e] = 0.f; b1[e] = 0.f;
#endif
#ifdef ZERO_O0
                    a0[e] = 0.f; a1[e] = 0.f;
#endif
                    s[8 * q + e] = a0[e] + b0[e]; s[8 * q + 4 + e] = a1[e] + b1[e]; } }
#pragma unroll
            for (int e = 0; e < 16; ++e) ss += s[e] * s[e];
            ss += __shfl_xor(ss, 1); ss += __shfl_xor(ss, 2); ss += __shfl_xor(ss, 4);
            const float rstd = 1.0f / sqrtf(ss * (1.0f / 128.0f) + NORM_EPS);
#pragma unroll
            for (int q = 0; q < 2; ++q) { f32x4 z0, z1; unpack8(*(const v4u*)(pz + 8 * q), z0, z1); const float* gp = gnw + (lane & 7) * 16 + 8 * q; const f32x4 g0 = *(const f32x4*)gp, g1 = *(const f32x4*)(gp + 4);
                f32x4 r0, r1;
#pragma unroll
                for (int e = 0; e < 4; ++e) { r0[e] = s[8 * q + e] * rstd * g0[e] * z0[e]; r1[e] = s[8 * q + 4 + e] * rstd * g1[e] * z1[e]; }
                *(v4u*)(p0 + 8 * q) = pack8(r0, r1); }
        }
        __syncthreads();
        LAS float* scr = (LAS float*)(lds + wave * 16384);
        constexpr int I_PA = 16 * 32, I_UP = 16 * 176, I_DN = 44 * 32, NIT = 3 * I_PA + I_UP + I_DN;
        for (int it = gw; it < NIT; it += NGW) { int r = it;
            if (r < I_PA) { transpose_item(args.in[I_WPA], 1024, WmT, 2048, 0, (r & 31) * 32, scr, r >> 5, r & 31, lane); continue; } r -= I_PA;
            if (r < I_PA) { transpose_item(args.in[I_WPD], 1024, WmT, 2048, 1024, (r & 31) * 32, scr, r >> 5, r & 31, lane); continue; } r -= I_PA;
            if (r < I_PA) { transpose_item(args.in[I_WOUT], 1024, WoT, 1024, 0, (r & 31) * 32, scr, r >> 5, r & 31, lane); continue; } r -= I_PA;
            if (r < I_UP) { const int kb = r / 176, nb = r - kb * 176; const int n0 = nb * 32; const bool isv = n0 >= 2816; const int c = isv ? n0 - 2816 : n0;
                const int drow = c < 1536 ? (isv ? 1536 + c : c) : (isv ? 3072 + 1280 + (c - 1536) : 3072 + (c - 1536));
                transpose_item(args.in[I_WUP], 5632, WupT, 1024, 0, drow, scr, kb, nb, lane); continue; } r -= I_UP;
            transpose_item(args.in[I_WDN], 1024, WdT, 2816, 0, (r & 31) * 32, scr, r >> 5, r & 31, lane);
        }
    }
    SEAM(6);
    if (IN(7)) { PH_LOCALS;
        pg8::Gemm g{A2, WmT, 1024, 2048, 2048}; pg8::StaticOrder S; S.init(64, 4, G, bx);
        EpiRow8<Merge1F> E{Merge1F{GATES, Y1}};
        pg8::gemm_phase<EpiRow8<Merge1F>, pg8::StaticOrder, true, true>(lds, g, S, E);
    }
    SEAM(7);
    if (IN(8)) { PH_LOCALS;
        pg8::Gemm g{A2 + 1024, WmT + 1024, 1024, 2048, 2048}; pg8::StaticOrder S; S.init(64, 4, G, bx);
        EpiRow8<Merge2F> E{Merge2F{GATES, Y1, Y}};
        pg8::gemm_phase<EpiRow8<Merge2F>, pg8::StaticOrder, true, true>(lds, g, S, E);
    }
    SEAM(8);
    if (IN(9)) { PH_LOCALS;
        pg8::Gemm g{Y, WoT, 1024, 1024, 1024}; pg8::StaticOrder S; S.init(64, 4, G, bx);
        EpiRow8<ResidF> E{ResidF{x, MOD, 2048, X1}};
        pg8::gemm_phase<EpiRow8<ResidF>, pg8::StaticOrder, true, true>(lds, g, S, E);
    }
    SEAM(9);
    if (IN(10)) { PH_LOCALS;
        for (int m = gw; m < M_LAT; m += NGW) { const int r = m >> 11; norm_mod_row_bf16(X1 + (size_t)m * 1024, MOD + r * 6144 + 3072, MOD + r * 6144 + 4096, H2 + (size_t)m * 1024, lane); }
    }
    SEAM(10);
#pragma unroll
    for (int half = 0; half < 2; ++half) {
        const int ncg = half == 0 ? 1536 : 1280, c0 = half == 0 ? 0 : 1536;
        if (IN(11 + 2 * half)) { PH_LOCALS;
            pg8::Gemm g{H2, WupT + (size_t)(half ? 3072 : 0) * 1024, 1024, 1024, 1024}; pg8::StaticOrder S; S.init(64, half == 0 ? 12 : 10, G, bx);
            EpiRow8<UpF> E{UpF{UR}};
            pg8::gemm_phase<EpiRow8<UpF>, pg8::StaticOrder, true, true>(lds, g, S, E);
        }
        SEAM(11 + 2 * half);
        if (IN(12 + 2 * half)) { PH_LOCALS;
            const float* cw = args.in[I_FCW]; const float* cb = args.in[I_FCB];
            const int ngrp = ncg / 8; const long total = (long)M_LAT * ngrp;
            for (long it = (long)vcu * 512 + tid; it < total; it += (long)G * 512) {
                const int m = (int)(it / ngrp), cgp = (int)(it - (long)m * ngrp), cl = cgp * 8, t = m & 2047;
                float gs[8], vs[8];
#pragma unroll
                for (int e = 0; e < 8; ++e) { gs[e] = cb[c0 + cl + e]; vs[e] = cb[2816 + c0 + cl + e]; }
#pragma unroll
                for (int tp = 0; tp < 3; ++tp) { const int tt = t + tp - 1; if (tt < 0 || tt > 2047) continue;
                    const bf16* ur = UR + (size_t)(m + tp - 1) * 3072 + cl; f32x4 a0, a1, b0, b1; unpack8(*(const v4u*)ur, a0, a1); unpack8(*(const v4u*)(ur + ncg), b0, b1);
                    const float* wg = cw + tp * 5632 + c0 + cl; const float* wv = wg + 2816;
#pragma unroll
                    for (int e = 0; e < 4; ++e) { gs[e] += wg[e] * a0[e]; gs[4 + e] += wg[4 + e] * a1[e]; vs[e] += wv[e] * b0[e]; vs[4 + e] += wv[4 + e] * b1[e]; } }
                f32x4 r0, r1;
#pragma unroll
                for (int e = 0; e < 4; ++e) { r0[e] = siluf_(gs[e]) * vs[e]; r1[e] = siluf_(gs[4 + e]) * vs[4 + e]; }
                *(v4u*)(ACT + (size_t)m * 2816 + c0 + cl) = pack8(r0, r1);
            }
        }
        SEAM(12 + 2 * half);
    }
    if (IN(15)) { PH_LOCALS;
        pg8::Gemm g{ACT, WdT, 2816, 2816, 2816}; pg8::StaticOrder S; S.init(64, 4, G, bx);
        EpiRow8<ResidF> E{ResidF{X1, MOD, 5120, X1}};
        pg8::gemm_phase<EpiRow8<ResidF>, pg8::StaticOrder, true, true>(lds, g, S, E);
    }
    SEAM(15);
    if (IN(16)) { PH_LOCALS;
        const float* fw = args.in[I_FNW];
        for (int m = gw; m < M_LAT; m += NGW) { f32x4 v[4]; float rstd; float* row = X1 + (size_t)m * 1024; rms_row(row, lane, v, rstd);
#pragma unroll
            for (int j = 0; j < 4; ++j) { const f32x4 w = ((const f32x4*)fw)[lane + 64 * j]; ((f32x4*)row)[lane + 64 * j] = v[j] * rstd * w; } }
    }
#undef IN
#undef SEAM
}

constexpr int N_PHASES = 17;
extern "C" void kernel_launch(void* const* d_in, const int* in_sizes, int n_in, void* d_out, int out_size, void* d_ws, size_t ws_size, hipStream_t stream) {
    static int grid = 0;
    if (grid == 0) {
        if (n_in != N_IN || in_sizes[0] != M_LAT * DM || out_size != M_LAT * DM || ws_size < WS_END) {
            fprintf(stderr, "kernel_launch: unexpected shapes: n_in %d in0 %d out %d ws %zu\n", n_in, n_in > 0 ? in_sizes[0] : -1, out_size, ws_size); grid = -1; return; }
        int dev = 0, cus = 0, per_cu = 0;
        if (hipGetDevice(&dev) != hipSuccess || hipDeviceGetAttribute(&cus, hipDeviceAttributeMultiprocessorCount, dev) != hipSuccess) { grid = -1; return; }
        if (hipFuncSetAttribute((const void*)fwd_kernel, hipFuncAttributeMaxDynamicSharedMemorySize, LDS_BYTES) != hipSuccess) { fprintf(stderr, "kernel_launch: hipFuncSetAttribute failed\n"); grid = -1; return; }
        if (hipOccupancyMaxActiveBlocksPerMultiprocessor(&per_cu, (const void*)fwd_kernel, NWAVES * 64, LDS_BYTES) != hipSuccess || per_cu < 1) { fprintf(stderr, "kernel_launch: occupancy query says %d blocks per CU\n", per_cu); (void)hipGetLastError(); grid = -1; return; }
        grid = cus;
        if (grid != 256) fprintf(stderr, "kernel_launch: note: %d CUs\n", grid);
    }
    if (grid < 0) return;
    if (hipMemsetAsync((char*)d_ws + WS_CTL, 0, CTL_ZERO_BYTES, stream) != hipSuccess) { fprintf(stderr, "kernel_launch: memset failed\n"); return; }
#ifdef EXP_POISON
    (void)hipMemsetAsync((char*)d_ws + CTL_ZERO_BYTES, 0xAA, WS_END - CTL_ZERO_BYTES, stream); (void)hipMemsetAsync(d_out, 0xAA, (size_t)out_size * 4, stream);
#endif
    Args a{};
    for (int i = 0; i < N_IN; ++i) a.in[i] = (const float*)d_in[i];
    a.out = (float*)d_out; a.ws = (unsigned char*)d_ws; a.ph_lo = 0; a.ph_hi = N_PHASES;
    void* kargs[] = {&a};
    hipError_t e = hipLaunchCooperativeKernel((const void*)fwd_kernel, dim3(grid), dim3(NWAVES * 64), kargs, LDS_BYTES, stream);
    if (e != hipSuccess) fprintf(stderr, "kernel_launch: launch failed: %s\n", hipGetErrorName(e));
}
```

```cpp
#include <hip/hip_runtime.h>
#include <cstdio>
#include <cstdint>

constexpr int DM = 1024, NB = 8, SEQ = 2048, CTXL = 256;
constexpr int M_LAT = NB * SEQ, M_CTX = NB * CTXL, M_ALL = M_LAT + M_CTX;
constexpr int KVLEN = CTXL + SEQ;
constexpr int DFF = 2816;
constexpr int NCH = KVLEN / 64;
constexpr float NORM_EPS = 1e-6f;
constexpr int WIN_ROWS = 7936, WIN_P2_TILES = 19, WIN_G_ROW0 = 4864;

constexpr size_t MiB = 1u << 20;
constexpr size_t WS_CTL = 0, CTL_ZERO_BYTES = 1 * MiB;
constexpr size_t WS_MOD = 1 * MiB;
constexpr size_t WS_ROPE = 1 * MiB + 256 * 1024;
constexpr size_t WS_HALO = 2 * MiB;
constexpr size_t WS_DBDA = 3 * MiB;
constexpr size_t WS_WIN = 6 * MiB;
constexpr size_t WS_K = 22 * MiB, WS_V = 31 * MiB;
constexpr size_t WS_A2 = 40 * MiB;
constexpr size_t WS_QKV = 104 * MiB;
constexpr size_t WS_TP = 212 * MiB;
constexpr size_t WS_VEC = 248 * MiB;
constexpr size_t WS_ZS = 104 * MiB;
constexpr size_t WS_GATES = 136 * MiB;
constexpr size_t WS_WM = 6 * MiB;
constexpr size_t WS_WO = 10 * MiB;
constexpr size_t WS_WUP = 12 * MiB;
constexpr size_t WS_WDN = 23 * MiB;
constexpr size_t WS_Y = 104 * MiB;
constexpr size_t WS_H2 = 29 * MiB;
constexpr size_t WS_ACT = 61 * MiB;
constexpr size_t WS_U = 149 * MiB;
constexpr size_t WS_SIDE = 150 * MiB;
constexpr size_t WS_END = 256 * MiB;
constexpr size_t DO_XN = 0, DO_O1 = 32 * MiB;

constexpr int CW_TMO = 0, CW_CODE = 1, CW_QUEUE = 64, CW_BAR = 4096;

constexpr int RING_BYTES = 131072;
constexpr int LDSX_OFF = RING_BYTES;
constexpr int LDSCTL_OFF = RING_BYTES + 12288, MISC_OFF = LDSCTL_OFF + 320;
constexpr int LDS_BYTES = 147456;

#define GAS __attribute__((address_space(1)))
#define LAS __attribute__((address_space(3)))
typedef unsigned short bf16;
typedef unsigned v4u __attribute__((ext_vector_type(4)));
typedef unsigned v2u __attribute__((ext_vector_type(2)));
typedef float f32x4 __attribute__((ext_vector_type(4)));
typedef float f32x2 __attribute__((ext_vector_type(2)));
typedef float f32x16 __attribute__((ext_vector_type(16)));
typedef short bf16x8 __attribute__((ext_vector_type(8)));
typedef short s16x4 __attribute__((ext_vector_type(4)));
typedef GAS unsigned gu32;
#define RLX_AGENT __ATOMIC_RELAXED, __HIP_MEMORY_SCOPE_AGENT
#define LDS_WAIT() asm volatile("s_waitcnt lgkmcnt(0)" ::: "memory")
#define VM_WAIT() asm volatile("s_waitcnt vmcnt(0)" ::: "memory")
#define SBAR() __builtin_amdgcn_sched_barrier(0)

__device__ __forceinline__ unsigned f2bf(float f) { unsigned u = __builtin_bit_cast(unsigned, f); return (u + 0x7fffu + ((u >> 16) & 1u)) >> 16; }
__device__ __forceinline__ unsigned pk2(float lo, float hi) { return f2bf(lo) | (f2bf(hi) << 16); }
__device__ __forceinline__ float bf2f(unsigned short h) { return __builtin_bit_cast(float, (unsigned)h << 16); }
__device__ __forceinline__ float bflo(unsigned w) { return __builtin_bit_cast(float, w << 16); }
__device__ __forceinline__ float bfhi(unsigned w) { return __builtin_bit_cast(float, w & 0xffff0000u); }
typedef __bf16 bf16x2_t __attribute__((ext_vector_type(2)));
__device__ __forceinline__ unsigned cvtpk(float lo, float hi) { f32x2 v = {lo, hi}; bf16x2_t b = __builtin_convertvector(v, bf16x2_t); return __builtin_bit_cast(unsigned, b); }
__device__ __forceinline__ float fast_exp(float x) { return __builtin_amdgcn_exp2f(x * 1.4426950408889634f); }
__device__ __forceinline__ float sigmoidf_(float x) { return __builtin_amdgcn_rcpf(1.f + fast_exp(-x)); }
__device__ __forceinline__ float siluf_(float x) { return x * sigmoidf_(x); }
__device__ __forceinline__ float wave_sum(float v) {
#pragma unroll
    for (int o = 1; o < 64; o <<= 1) v += __shfl_xor(v, o);
    return v;
}
__device__ __forceinline__ int tidx() { int t = threadIdx.x; asm volatile("" : "+v"(t)); return t; }
#define XB_TMO      128
#define XB_XCNT(j)  (256  + 64 * (j))
#define XB_XSUB(j)  (1280 + 64 * (j))
#define XB_XGEN(j)  (2304 + 64 * (j))
#define XB_TOP      3328
#define XB_TOPGEN   3392
#define XCD_BAR_WORDS 3456
#define XB_SPIN_CAP (1u << 18)

__device__ __forceinline__ unsigned xb_ld(unsigned* p)              { return __hip_atomic_load(p, __ATOMIC_RELAXED, __HIP_MEMORY_SCOPE_AGENT); }
__device__ __forceinline__ unsigned xb_add(unsigned* p, unsigned v) { return __hip_atomic_fetch_add(p, v, __ATOMIC_RELAXED, __HIP_MEMORY_SCOPE_AGENT); }
__device__ __forceinline__ unsigned xb_xcc_id() { return (unsigned)__builtin_amdgcn_s_getreg((3 << 11) | 20) & 0xFu; }
#define XB_SPIN(cond, bar) do { unsigned _sp = 0; while (cond) { __builtin_amdgcn_s_sleep(1); \
    if ((++_sp & 255u) == 0u) { if (xb_ld(&(bar)[XB_TMO])) break; if (_sp > XB_SPIN_CAP) { atomicAdd(&(bar)[XB_TMO], 1u); break; } } } } while (0)

struct XcdBarrier {
    unsigned* bar; unsigned x;
    volatile LAS unsigned* st;
};

__device__ __forceinline__ XcdBarrier xcd_barrier_post(unsigned* bar, volatile LAS unsigned* st) {
    XcdBarrier b; b.bar = bar; b.x = xb_xcc_id(); b.st = st;
    if (tidx() == 0) (void)xb_add(&bar[XB_XCNT(b.x)], 1u);
    return b;
}
__device__ __forceinline__ void xcd_barrier_complete(unsigned* bar, unsigned x, unsigned& nloc, unsigned& nx) {
    const unsigned G = gridDim.x * gridDim.y * gridDim.z;
    unsigned sum, cnt, mine, sp = 0u;
    for (;;) {
        sum = 0u; cnt = 0u; mine = 0u;
#pragma unroll
        for (unsigned j = 0; j < 16; ++j) { const unsigned c = xb_ld(&bar[XB_XCNT(j)]); sum += c; cnt += (c > 0u) ? 1u : 0u; mine = (j == x) ? c : mine; }
        if (sum == G) break;
        __builtin_amdgcn_s_sleep(1);
        if ((++sp & 255u) == 0u) { if (xb_ld(&bar[XB_TMO])) break; if (sp > XB_SPIN_CAP) { atomicAdd(&bar[XB_TMO], 1u); break; } }
    }
    nloc = mine > 0u ? mine : 1u; nx = cnt > 0u ? cnt : 1u;
}

__device__ __forceinline__ void xcd_barrier(const XcdBarrier& b) {
    asm volatile("s_waitcnt vmcnt(0)" ::: "memory");
    __syncthreads();
    if (tidx() == 0) {
        unsigned* bar = b.bar;
        __builtin_amdgcn_s_waitcnt(0);
        unsigned nloc = b.st[0], nx = b.st[1];
        if (nloc == 0u) { xcd_barrier_complete(bar, b.x, nloc, nx); b.st[0] = nloc; b.st[1] = nx; }
        const unsigned old = xb_add(&bar[XB_XSUB(b.x)], 1u);
        const unsigned gen = old / nloc;
        if (old + 1u == (gen + 1u) * nloc) {
            __builtin_amdgcn_fence(__ATOMIC_RELEASE, "agent");
            asm volatile("s_waitcnt vmcnt(0)" ::: "memory");
            const unsigned og = xb_add(&bar[XB_TOP], 1u);
            const unsigned tg = og / nx;
            if (og + 1u == (tg + 1u) * nx) xb_add(&bar[XB_TOPGEN], 1u);
            else XB_SPIN(xb_ld(&bar[XB_TOPGEN]) == tg, bar);
            __builtin_amdgcn_fence(__ATOMIC_ACQUIRE, "agent");
            xb_add(&bar[XB_XGEN(b.x)], 1u);
            asm volatile("s_waitcnt vmcnt(0)" ::: "memory");
        } else {
            XB_SPIN(xb_ld(&bar[XB_XGEN(b.x)]) == gen, bar);
            __builtin_amdgcn_fence(__ATOMIC_ACQUIRE, "agent");
            asm volatile("s_waitcnt vmcnt(0)" ::: "memory");
        }
    }
    __syncthreads();
}
namespace pg8 {
#define PG8_LAS __attribute__((address_space(3)))
typedef unsigned short bf16_t;
typedef unsigned u32x4 __attribute__((ext_vector_type(4)));
constexpr int BM = 256, BK = 64, HALF = 128, HTB = HALF * BK * 2  , STAGE_BYTES = 8 * HTB, NXCD = 8, WGM = 8;
__host__ __device__ __forceinline__ int lds_byte(int r, int c) { const int st = (r >> 4) * 2 + (c >> 5), rr = r & 15, cc = c & 31, ob = rr * 64 + cc * 2; return st * 1024 + (ob ^ (((ob >> 9) & 1) << 5)); }
__host__ __device__ __forceinline__ void stage_rc(int b, int& R, int& C) { const int st = b / 1024, sb = b % 1024, swz = sb ^ (((sb >> 9) & 1) << 5); R = (st >> 1) * 16 + swz / 64; C = (st & 1) * 32 + (swz % 64) / 2; }
__host__ __device__ __forceinline__ int perm32(int rho) { const int n = rho >> 4, i = rho & 15; return 8 * (i >> 2) + 4 * n + (i & 3); }
struct Unit { int pm, pn; };
struct Gemm { const bf16_t* A; const bf16_t* Bt; int K, lda, ldb; };
struct StaticOrder {
    int nM, nN, nwg, G, c;
    __host__ __device__ __forceinline__ void init(int nM_, int nN_, int G_, int c_) { nM = nM_; nN = nN_; nwg = nM * nN; G = G_; c = c_; }
    __host__ __device__ __forceinline__ bool next(int i, Unit& u) const {
        const long L = (long)i * G + c; if (L >= nwg) return false;
        int wgid = (int)L; { const int q = nwg / NXCD, r = nwg % NXCD, xcd = wgid % NXCD, off = wgid / NXCD; wgid = (xcd < r ? xcd * (q + 1) : r * (q + 1) + (xcd - r) * q) + off; }
        const int nig = WGM * nN, gid = wgid / nig, fm = gid * WGM, gsz = (nM - fm) < WGM ? (nM - fm) : WGM;
        u.pm = fm + ((wgid % nig) % gsz); u.pn = (wgid % nig) / gsz; return true;
    }
    __device__ __forceinline__ void a_ready(const Unit&) const {}
    __device__ __forceinline__ void done(const Unit&) const {}
};
template <class Epi, class Sched, bool ALIGN_EPI = false, bool SP2 = false>
__device__ __forceinline__ void gemm_phase(PG8_LAS unsigned char* lds, const Gemm g, const Sched& S, const Epi& E) {
    const int tid = tidx(), wid = __builtin_amdgcn_readfirstlane(tid >> 6), lane = tid & 63, wr = wid >> 2, wc = wid & 3, fr = lane & 15, fq = lane >> 4;
    const int K = g.K, nt = K / BK, lda = g.lda, ldb = g.ldb;
    unsigned voffA[2], voffB[2];
#pragma unroll
    for (int i = 0; i < 2; ++i) { int R, C; stage_rc(tid * 16 + i * 8192, R, C); const int Rb = Epi::PERM ? ((R & ~31) + perm32(R & 31)) : R;
        voffA[i] = (unsigned)(R * lda + C) * 2u; voffB[i] = (unsigned)(Rb * ldb + C) * 2u; }
    const size_t kstep = (size_t)(BK * 2);
    const size_t hstepA = (size_t)HALF * lda * 2, hstepB = (size_t)HALF * ldb * 2;
    const size_t tstepA = 2 * hstepA, tstepB = 2 * hstepB;
    const unsigned ldsw = (unsigned)wid * 1024u;
    const int aoff = lds_byte(wr * 64 + fr, fq * 8), boff = lds_byte(wc * 32 + fr, fq * 8);
#define PG8_SA(b, h) (((b) * 2 + (h)) * HTB)
#define PG8_SB(b, h) ((4 + (b) * 2 + (h)) * HTB)
#define PG8_STAGE(bufoff, gbase, voff) do { _Pragma("unroll") for (int _i = 0; _i < 2; ++_i) \
        __builtin_amdgcn_global_load_lds((const unsigned*)((const char*)(gbase) + (voff)[_i]), (PG8_LAS unsigned*)(lds + (bufoff) + ldsw + _i * 8192), 16, 0, 0); } while (0)
#define PG8_LDA(dst, b, h) do { _Pragma("unroll") for (int m = 0; m < 4; ++m) _Pragma("unroll") for (int k = 0; k < 2; ++k) dst[m][k] = *(const PG8_LAS bf16x8*)(lds + PG8_SA(b, h) + aoff + m * 2048 + k * 1024); } while (0)
#define PG8_LDB(dst, b, h) do { _Pragma("unroll") for (int n = 0; n < 2; ++n) _Pragma("unroll") for (int k = 0; k < 2; ++k) dst[n][k] = *(const PG8_LAS bf16x8*)(lds + PG8_SB(b, h) + boff + n * 2048 + k * 1024); } while (0)
#define PG8_MMA(ai, bj, At, Bt) do { __builtin_amdgcn_s_setprio(1); _Pragma("unroll") for (int m = 0; m < 4; ++m) _Pragma("unroll") for (int n = 0; n < 2; ++n) _Pragma("unroll") for (int k = 0; k < 2; ++k) \
        acc[ai][bj][m][n] = __builtin_amdgcn_mfma_f32_16x16x32_bf16(Bt[n][k], At[m][k], acc[ai][bj][m][n], 0, 0, 0); __builtin_amdgcn_s_setprio(0); } while (0)
#define PG8_WAIT_V(n) asm volatile("s_waitcnt vmcnt(" #n ")" ::: "memory")
#define PG8_WAIT_L(n) asm volatile("s_waitcnt lgkmcnt(" #n ")" ::: "memory")
#define PG8_BAR __builtin_amdgcn_s_barrier()
#define PG8_SCHED __builtin_amdgcn_sched_barrier(0)
    Unit cur, nxt; int ui = 0;
    if (!S.next(0, cur)) return;
    f32x4 acc[2][2][4][2];
#pragma unroll
    for (int a = 0; a < 2; ++a)
#pragma unroll
        for (int b = 0; b < 2; ++b)
#pragma unroll
            for (int m = 0; m < 4; ++m)
#pragma unroll
                for (int n = 0; n < 2; ++n) acc[a][b][m][n] = (f32x4){0.f, 0.f, 0.f, 0.f};
    bf16x8 At[4][2], B0[2][2], B1[2][2];
    const char* cA = (const char*)g.A + (size_t)cur.pm * tstepA; const char* cB = (const char*)g.Bt + (size_t)cur.pn * tstepB;
    S.a_ready(cur);
    if constexpr (SP2) {
        PG8_STAGE(PG8_SB(0, 0), cB, voffB); PG8_STAGE(PG8_SB(0, 1), cB + hstepB, voffB); PG8_STAGE(PG8_SA(0, 0), cA, voffA); PG8_STAGE(PG8_SA(0, 1), cA + hstepA, voffA);
        if (wr == 1) PG8_BAR;
        PG8_WAIT_V(2); PG8_BAR;
        PG8_STAGE(PG8_SB(1, 0), cB + kstep, voffB); PG8_STAGE(PG8_SA(1, 0), cA + kstep, voffA); PG8_STAGE(PG8_SB(1, 1), cB + hstepB + kstep, voffB);
        PG8_WAIT_V(6); PG8_BAR;
    } else {
        PG8_STAGE(PG8_SB(0, 0), cB, voffB); PG8_STAGE(PG8_SA(0, 0), cA, voffA); PG8_STAGE(PG8_SB(0, 1), cB + hstepB, voffB); PG8_STAGE(PG8_SA(0, 1), cA + hstepA, voffA);
        if (wr == 1) PG8_BAR;
        PG8_WAIT_V(4); PG8_BAR;
        PG8_STAGE(PG8_SB(1, 0), cB + kstep, voffB); PG8_STAGE(PG8_SA(1, 0), cA + kstep, voffA); PG8_STAGE(PG8_SB(1, 1), cB + hstepB + kstep, voffB);
        PG8_WAIT_V(6); PG8_BAR;
    }
    for (;;) {
        const bool has_next = S.next(ui + 1, nxt);
        const char* nA = has_next ? (const char*)g.A + (size_t)nxt.pm * tstepA : cA; const char* nB = has_next ? (const char*)g.Bt + (size_t)nxt.pn * tstepB : cB;
        for (int t = 0; t < nt; t += 2) {
            const bool last = (t == nt - 2);
            const char* a1 = cA + (size_t)(t + 1) * kstep;
            const char* a2 = last ? nA : cA + (size_t)(t + 2) * kstep; const char* b2 = last ? nB : cB + (size_t)(t + 2) * kstep;
            const char* a3 = a2 + kstep; const char* b3 = b2 + kstep;
            if (last && has_next) S.a_ready(nxt);
            if constexpr (SP2) {
            PG8_LDB(B0, 0, 0); PG8_LDB(B1, 0, 1); PG8_SCHED; PG8_LDA(At, 0, 0); PG8_STAGE(PG8_SA(1, 1), a1 + hstepA, voffA);
            PG8_WAIT_V(8); PG8_WAIT_L(0); PG8_BAR; PG8_MMA(0, 0, At, B0); PG8_MMA(0, 1, At, B1); PG8_BAR; PG8_SCHED;
            PG8_LDA(At, 0, 1); PG8_STAGE(PG8_SB(0, 0), b2, voffB); PG8_STAGE(PG8_SB(0, 1), b2 + hstepB, voffB); PG8_STAGE(PG8_SA(0, 0), a2, voffA);
            PG8_WAIT_V(8); PG8_WAIT_L(0); PG8_BAR; PG8_MMA(1, 0, At, B0); PG8_MMA(1, 1, At, B1); PG8_BAR; PG8_SCHED;
            PG8_LDB(B0, 1, 0); PG8_LDB(B1, 1, 1); PG8_SCHED; PG8_LDA(At, 1, 0); PG8_STAGE(PG8_SA(0, 1), a2 + hstepA, voffA);
            PG8_WAIT_V(8); PG8_WAIT_L(0); PG8_BAR; PG8_MMA(0, 0, At, B0); PG8_MMA(0, 1, At, B1); PG8_BAR; PG8_SCHED;
            PG8_LDA(At, 1, 1); PG8_STAGE(PG8_SB(1, 0), b3, voffB); PG8_STAGE(PG8_SB(1, 1), b3 + hstepB, voffB); PG8_STAGE(PG8_SA(1, 0), a3, voffA);
            PG8_WAIT_V(8); PG8_WAIT_L(0); PG8_BAR; PG8_MMA(1, 0, At, B0); PG8_MMA(1, 1, At, B1); PG8_BAR; PG8_SCHED;
            } else {
            PG8_LDB(B0, 0, 0); PG8_SCHED; PG8_LDA(At, 0, 0); PG8_STAGE(PG8_SA(1, 1), a1 + hstepA, voffA);
            PG8_WAIT_L(8); PG8_BAR; PG8_WAIT_L(0); PG8_MMA(0, 0, At, B0); PG8_BAR; PG8_SCHED;
            PG8_LDB(B1, 0, 1); PG8_STAGE(PG8_SB(0, 0), b2, voffB);
            PG8_BAR; PG8_WAIT_L(0); PG8_MMA(0, 1, At, B1); PG8_BAR;
            PG8_LDA(At, 0, 1); PG8_STAGE(PG8_SA(0, 0), a2, voffA);
            PG8_BAR; PG8_WAIT_L(0); PG8_MMA(1, 0, At, B0); PG8_BAR; PG8_SCHED;
            PG8_STAGE(PG8_SB(0, 1), b2 + hstepB, voffB);
            PG8_WAIT_V(6); PG8_BAR; PG8_MMA(1, 1, At, B1); PG8_BAR;
            PG8_LDB(B0, 1, 0); PG8_SCHED; PG8_LDA(At, 1, 0); PG8_STAGE(PG8_SA(0, 1), a2 + hstepA, voffA);
            PG8_WAIT_L(8); PG8_BAR; PG8_WAIT_L(0); PG8_MMA(0, 0, At, B0); PG8_BAR; PG8_SCHED;
            PG8_LDB(B1, 1, 1); PG8_STAGE(PG8_SB(1, 0), b3, voffB);
            PG8_BAR; PG8_WAIT_L(0); PG8_MMA(0, 1, At, B1); PG8_BAR;
            PG8_LDA(At, 1, 1); PG8_STAGE(PG8_SA(1, 0), a3, voffA);
            PG8_BAR; PG8_WAIT_L(0); PG8_MMA(1, 0, At, B0); PG8_BAR; PG8_SCHED;
            PG8_STAGE(PG8_SB(1, 1), b3 + hstepB, voffB);
            PG8_WAIT_V(6); PG8_BAR; PG8_MMA(1, 1, At, B1); PG8_BAR;
            }
        }
        if constexpr (ALIGN_EPI) { if (wr == 0) PG8_BAR; }
        if constexpr (!Epi::AFTER_DRAIN) { E(acc, cur, wr, wc, fr, fq); S.done(cur); }
        if (!has_next) break;
#pragma unroll
        for (int a = 0; a < 2; ++a)
#pragma unroll
            for (int b = 0; b < 2; ++b)
#pragma unroll
                for (int m = 0; m < 4; ++m)
#pragma unroll
                    for (int n = 0; n < 2; ++n) acc[a][b][m][n] = (f32x4){0.f, 0.f, 0.f, 0.f};
        cur = nxt; cA = nA; cB = nB; ++ui;
        if constexpr (ALIGN_EPI) { if (wr == 1) PG8_BAR; }
    }
    PG8_WAIT_V(0);
    if constexpr (!ALIGN_EPI) { if (wr == 0) PG8_BAR; }
    PG8_BAR;
    if constexpr (Epi::AFTER_DRAIN) { E.fused(acc, cur, wr, wc, fr, fq, lds, wid, lane); S.done(cur); }
#undef PG8_SA
#undef PG8_SB
#undef PG8_STAGE
#undef PG8_LDA
#undef PG8_LDB
#undef PG8_MMA
#undef PG8_WAIT_V
#undef PG8_WAIT_L
#undef PG8_BAR
#undef PG8_SCHED
}
}
namespace att {
constexpr int D = 128, NW = 8, QBLK = 32, KVBLK = 64;
constexpr float SCALE = 0.088388347648318440f;
constexpr float THR = 8.f;
constexpr int LDQ = 2048, LDK = 256, LDO = 2048;
constexpr size_t SHM_V = KVBLK * D * 2, SHM_K = KVBLK * D * 2, SHM_ATTN = 2 * SHM_V + 2 * SHM_K + NW * 64 * 4;
#define KSWZ(row, colB) ((row) * 256 + ((colB) ^ (((row) & 7) << 4)))
__device__ __forceinline__ int crow(int r, int hi) { return (r & 3) + 8 * (r >> 2) + 4 * hi; }
__device__ __forceinline__ void partialSM(f32x16& p0, f32x16& p1, float& m_reg, float& mn, float& alpha) {
  constexpr float C = SCALE * 1.4426950408889634f;
  float pmax = p0[0];
#pragma unroll
  for (int r = 1; r < 16; ++r) pmax = fmaxf(pmax, p0[r]);
#pragma unroll
  for (int r = 0; r < 16; ++r) pmax = fmaxf(pmax, p1[r]);
  { auto rr = __builtin_amdgcn_permlane32_swap(__float_as_uint(pmax), __float_as_uint(pmax), false, false);
    pmax = fmaxf(__uint_as_float(rr[0]), __uint_as_float(rr[1])); }
  if (__builtin_expect(__all(pmax - m_reg <= THR / SCALE), 1)) { mn = m_reg; alpha = 1.f; }
  else { mn = fmaxf(m_reg, pmax); alpha = __builtin_amdgcn_exp2f((m_reg - mn) * C); m_reg = mn; }
  float mnC = -mn * C;
#pragma unroll
  for (int r = 0; r < 16; ++r) p0[r] = fmaf(p0[r], C, mnC);
#pragma unroll
  for (int r = 0; r < 16; ++r) p1[r] = fmaf(p1[r], C, mnC);
#pragma unroll
  for (int r = 0; r < 16; ++r) p0[r] = __builtin_amdgcn_exp2f(p0[r]);
}
__device__ __forceinline__ void finishSM(f32x16& p0, f32x16& p1, float alpha, float& l_reg, bf16x8& pa0, bf16x8& pa1, bf16x8& pa2, bf16x8& pa3) {
#pragma unroll
  for (int r = 0; r < 16; ++r) p1[r] = __builtin_amdgcn_exp2f(p1[r]);
  float ps = 0;
#pragma unroll
  for (int r = 0; r < 16; ++r) ps += p0[r];
#pragma unroll
  for (int r = 0; r < 16; ++r) ps += p1[r];
  { auto rr = __builtin_amdgcn_permlane32_swap(__float_as_uint(ps), __float_as_uint(ps), false, false);
    ps = __uint_as_float(rr[0]) + __uint_as_float(rr[1]); }
  l_reg = l_reg * alpha + ps;
#define PK4(P, BASE, OUT) do { unsigned a0 = cvtpk(P[BASE + 0], P[BASE + 1]), a1 = cvtpk(P[BASE + 2], P[BASE + 3]);   \
    unsigned b0 = cvtpk(P[BASE + 4], P[BASE + 5]), b1 = cvtpk(P[BASE + 6], P[BASE + 7]);                              \
    auto r0 = __builtin_amdgcn_permlane32_swap(a0, b0, false, false); auto r1 = __builtin_amdgcn_permlane32_swap(a1, b1, false, false); \
    v4u w = {r0[0], r1[0], r0[1], r1[1]}; OUT = __builtin_bit_cast(bf16x8, w); } while (0)
  PK4(p0, 0, pa0); PK4(p0, 8, pa1); PK4(p1, 0, pa2); PK4(p1, 8, pa3);
#undef PK4
}
__device__ __forceinline__ void qkt(f32x16& p0, f32x16& p1, const bf16* Ks, const bf16x8* qr, int r32, int hi) {
  p0 = f32x16{}; p1 = f32x16{};
#pragma unroll
  for (int d0 = 0; d0 < 8; ++d0) { int cb = (d0 * 16 + hi * 8) * 2;
    bf16x8 b0 = *reinterpret_cast<const bf16x8*>((const char*)Ks + KSWZ(r32, cb));
    bf16x8 b1 = *reinterpret_cast<const bf16x8*>((const char*)Ks + KSWZ(32 + r32, cb));
    p0 = __builtin_amdgcn_mfma_f32_32x32x16_bf16(b0, qr[d0], p0, 0, 0, 0);
    p1 = __builtin_amdgcn_mfma_f32_32x32x16_bf16(b1, qr[d0], p1, 0, 0, 0); }
}
__device__ __forceinline__ int v_st(int k, int c) { const int kk = (k & ~0xC) | ((k & 4) << 1) | ((k & 8) >> 1); return ((kk >> 3) * 4 + (c >> 5)) * 512 + ((kk & 7) * 32 + (c & 31)) * 2; }
__device__ __forceinline__ int v_rd_base(int lane) { return ((lane & 3) << 3) | (((lane >> 2) & 3) << 6) | (((lane >> 4) & 1) << 5) | (((lane >> 5) & 1) << 8); }
constexpr int v_rd_off(int d0, int ks, int half) { return d0 * 512 + ks * 4096 + half * 2048; }
template <int OFF> __device__ __forceinline__ s16x4 tr_read(int vb) {
  s16x4 r; asm volatile("ds_read_b64_tr_b16 %0, %1 offset:%2" : "=&v"(r) : "v"(vb), "i"(OFF) : "memory"); return r;
}
template <int D0> __device__ __forceinline__ void pv_one(f32x16& od, int vb, bf16x8 pa0, bf16x8 pa1, bf16x8 pa2, bf16x8 pa3) {
  const s16x4 l0 = tr_read<v_rd_off(D0, 0, 0)>(vb), h0 = tr_read<v_rd_off(D0, 0, 1)>(vb), l1 = tr_read<v_rd_off(D0, 1, 0)>(vb), h1 = tr_read<v_rd_off(D0, 1, 1)>(vb);
  const s16x4 l2 = tr_read<v_rd_off(D0, 2, 0)>(vb), h2 = tr_read<v_rd_off(D0, 2, 1)>(vb), l3 = tr_read<v_rd_off(D0, 3, 0)>(vb), h3 = tr_read<v_rd_off(D0, 3, 1)>(vb);
  asm volatile("s_waitcnt lgkmcnt(0)" ::: "memory"); SBAR();
#define PK(L, H) (bf16x8){L[0], L[1], L[2], L[3], H[0], H[1], H[2], H[3]}
  od = __builtin_amdgcn_mfma_f32_32x32x16_bf16(pa0, PK(l0, h0), od, 0, 0, 0);
  od = __builtin_amdgcn_mfma_f32_32x32x16_bf16(pa1, PK(l1, h1), od, 0, 0, 0);
  od = __builtin_amdgcn_mfma_f32_32x32x16_bf16(pa2, PK(l2, h2), od, 0, 0, 0);
  od = __builtin_amdgcn_mfma_f32_32x32x16_bf16(pa3, PK(l3, h3), od, 0, 0, 0);
#undef PK
}
__device__ __forceinline__ void pv_d0(f32x16* o, int vb, bf16x8 pa0, bf16x8 pa1, bf16x8 pa2, bf16x8 pa3) {
  pv_one<0>(o[0], vb, pa0, pa1, pa2, pa3); pv_one<1>(o[1], vb, pa0, pa1, pa2, pa3); pv_one<2>(o[2], vb, pa0, pa1, pa2, pa3); pv_one<3>(o[3], vb, pa0, pa1, pa2, pa3);
}
__device__ __forceinline__ void attn_unit(bf16* Qb, const bf16* __restrict__ Kh, const bf16* __restrict__ Vh, int tpos0, const float* __restrict__ qnw, const float* __restrict__ rope, int seq, char* lds) {
  const int tid = tidx(), wid = tid >> 6, lane = tid & 63, r32 = lane & 31, hi = lane >> 5;
  bf16* V_lds = (bf16*)lds; bf16* K_lds = (bf16*)(lds + 2 * SHM_V);
  float* ws = (float*)(lds + 2 * SHM_V + 2 * SHM_K) + wid * 64; float* li_l = ws; float* al_l = ws + 32;
  float m_reg = -1e30f, l_reg = 0; f32x16 o[4] = {}; bf16x8 qr[8];
  {
    const bf16* Qw = Qb + (long)(wid * QBLK + r32) * LDQ + hi * 8;
    float xf[8][8]; float ss = 0.f;
#pragma unroll
    for (int d0 = 0; d0 < 8; ++d0) { const v4u raw = *reinterpret_cast<const v4u*>(Qw + d0 * 16);
#pragma unroll
      for (int e = 0; e < 4; ++e) { xf[d0][2 * e] = bflo(raw[e]); xf[d0][2 * e + 1] = bfhi(raw[e]); } }
#pragma unroll
    for (int d0 = 0; d0 < 8; ++d0)
#pragma unroll
      for (int e = 0; e < 8; ++e) ss += xf[d0][e] * xf[d0][e];
    { auto rr = __builtin_amdgcn_permlane32_swap(__float_as_uint(ss), __float_as_uint(ss), false, false); ss = __uint_as_float(rr[0]) + __uint_as_float(rr[1]); }
    const float rstd = 1.0f / sqrtf(ss * (1.0f / 128.0f) + NORM_EPS);
#pragma unroll
    for (int d0 = 0; d0 < 8; ++d0) { const f32x4 w0 = *(const f32x4*)(qnw + d0 * 16 + hi * 8), w1 = *(const f32x4*)(qnw + d0 * 16 + hi * 8 + 4);
#pragma unroll
      for (int e = 0; e < 4; ++e) { xf[d0][e] *= rstd * w0[e]; xf[d0][4 + e] *= rstd * w1[e]; } }
    const int t = tpos0 + wid * QBLK + r32, prow = t >> 6, pcol = t & 63;
#pragma unroll
    for (int ax = 0; ax < 2; ++ax) { const float* tb = rope + (size_t)(ax ? pcol : prow) * 64;
#pragma unroll
      for (int dd = 0; dd < 2; ++dd) { const int d0 = 4 * ax + dd;
#pragma unroll
        for (int e = 0; e < 8; ++e) { const f32x2 cs = *(const f32x2*)(tb + 2 * (16 * dd + 8 * hi + e));
          const float x1 = xf[d0][e], x2 = xf[d0 + 2][e]; xf[d0][e] = x1 * cs.x - x2 * cs.y; xf[d0 + 2][e] = x2 * cs.x + x1 * cs.y; } } }
#pragma unroll
    for (int d0 = 0; d0 < 8; ++d0) { v4u w = {cvtpk(xf[d0][0], xf[d0][1]), cvtpk(xf[d0][2], xf[d0][3]), cvtpk(xf[d0][4], xf[d0][5]), cvtpk(xf[d0][6], xf[d0][7])}; qr[d0] = __builtin_bit_cast(bf16x8, w); }
  }
  const int sr = tid >> 4, sc = (tid & 15) * 8, vst0 = v_st(sr, sc), vst1 = v_st(32 + sr, sc);
  const int vb0 = (int)(uintptr_t)V_lds + v_rd_base(lane);
  struct { bf16x8 vs0, vs1, ks0, ks1; } sr_[2];
#define SLOAD(i, k0) do { sr_[i].vs0 = *(const bf16x8*)(&Vh[(long)((k0) + sr) * LDK + sc]); sr_[i].vs1 = *(const bf16x8*)(&Vh[(long)((k0) + 32 + sr) * LDK + sc]); \
    sr_[i].ks0 = *(const bf16x8*)(&Kh[(long)((k0) + sr) * LDK + sc]); sr_[i].ks1 = *(const bf16x8*)(&Kh[(long)((k0) + 32 + sr) * LDK + sc]); } while (0)
#define SWRITE(b, i) do { *(bf16x8*)((char*)V_lds + (b) * SHM_V + vst0) = sr_[i].vs0;          \
    *(bf16x8*)((char*)V_lds + (b) * SHM_V + vst1) = sr_[i].vs1; int kc = sc * 2;               \
    *(bf16x8*)((char*)K_lds + (b) * SHM_K + KSWZ(sr, kc)) = sr_[i].ks0;                       \
    *(bf16x8*)((char*)K_lds + (b) * SHM_K + KSWZ(32 + sr, kc)) = sr_[i].ks1; } while (0)
#define SWAIT() asm volatile("s_waitcnt vmcnt(4)" ::: "memory")
#define RESC(a) do { if (__any((a) < 1.f)) { if (hi == 0) al_l[r32] = (a); asm volatile("s_waitcnt lgkmcnt(0)" ::: "memory"); \
    _Pragma("unroll") for (int d = 0; d < 4; ++d) _Pragma("unroll") for (int r = 0; r < 16; ++r) o[d][r] *= al_l[crow(r, hi)]; } } while (0)
  f32x16 pA0, pA1, pB0, pB1; float mnA, mnB, alA, alB; bf16x8 pa0, pa1, pa2, pa3; const int NT = seq / KVBLK;
  constexpr int SE = 0, SO = 1;
  SLOAD(SE, 0); asm volatile("s_waitcnt vmcnt(0)" ::: "memory"); SWRITE(0, SE); __syncthreads();
  qkt(pA0, pA1, K_lds, qr, r32, hi); partialSM(pA0, pA1, m_reg, mnA, alA);
  SLOAD(SO, KVBLK); if (2 < NT) SLOAD(SE, 2 * KVBLK);
  SWAIT(); SWRITE(1, SO); __syncthreads();
  for (int j = 1; j + 1 < NT; j += 2) {
    SBAR(); qkt(pB0, pB1, (bf16*)((char*)K_lds + SHM_K), qr, r32, hi);
    finishSM(pA0, pA1, alA, l_reg, pa0, pa1, pa2, pa3); SBAR();
    SLOAD(SO, (j + 2) * KVBLK); SBAR();
    pv_d0(o, vb0, pa0, pa1, pa2, pa3); partialSM(pB0, pB1, m_reg, mnB, alB);
    __syncthreads(); SWAIT(); SWRITE(0, SE);
    RESC(alB); __syncthreads();
    SBAR(); qkt(pA0, pA1, K_lds, qr, r32, hi);
    finishSM(pB0, pB1, alB, l_reg, pa0, pa1, pa2, pa3); SBAR();
    if (j + 3 < NT) SLOAD(SE, (j + 3) * KVBLK); SBAR();
    pv_d0(o, vb0 + (int)SHM_V, pa0, pa1, pa2, pa3); partialSM(pA0, pA1, m_reg, mnA, alA);
    __syncthreads(); SWAIT(); SWRITE(1, SO);
    RESC(alA); __syncthreads();
  }
  SBAR(); qkt(pB0, pB1, (bf16*)((char*)K_lds + SHM_K), qr, r32, hi);
  finishSM(pA0, pA1, alA, l_reg, pa0, pa1, pa2, pa3); SBAR();
  pv_d0(o, vb0, pa0, pa1, pa2, pa3); partialSM(pB0, pB1, m_reg, mnB, alB);
  __syncthreads(); RESC(alB);
  finishSM(pB0, pB1, alB, l_reg, pa0, pa1, pa2, pa3); SBAR();
  pv_d0(o, vb0 + (int)SHM_V, pa0, pa1, pa2, pa3);
  if (hi == 0) li_l[r32] = l_reg; asm volatile("s_waitcnt lgkmcnt(0)" ::: "memory");
  float rli[16];
#pragma unroll
  for (int r = 0; r < 16; ++r) rli[r] = __builtin_amdgcn_rcpf(li_l[crow(r, hi)]);
  bf16* Ow = Qb + (long)(wid * QBLK) * LDO;
#pragma unroll
  for (int r = 0; r < 16; ++r) { int orow = crow(r, hi);
#pragma unroll
    for (int d0 = 0; d0 < 4; ++d0) Ow[(long)orow * LDO + d0 * 32 + r32] = (bf16)f2bf(o[d0][r] * rli[r]); }
  asm volatile("s_waitcnt vmcnt(0)" ::: "memory");
#undef SLOAD
#undef SWRITE
#undef SWAIT
#undef RESC
}
#undef KSWZ
}
namespace gdn {
__device__ __forceinline__ int crow(int r, int hi) { return (r & 3) + 8 * (r >> 2) + 4 * hi; }
__device__ __forceinline__ unsigned off_b(unsigned row, unsigned ch) { return 256u * row + 16u * (ch ^ (((row & 3) << 2) | ((row >> 2) & 3))); }
__device__ __forceinline__ unsigned off_t(unsigned row, unsigned ch) { return 128u * row + 16u * (ch ^ ((row >> 1) & 7)); }
__host__ __device__ constexpr int swz16(int p) { return (p & ~12) | ((p & 4) << 1) | ((p & 8) >> 1); }
typedef short v4i16_t __attribute__((ext_vector_type(4)));
__device__ __forceinline__ float readlane_f(float x, int l) { return __builtin_bit_cast(float, __builtin_amdgcn_readlane(__builtin_bit_cast(int, x), l)); }
__device__ __forceinline__ s16x4 vtr(LAS unsigned char* p) { return __builtin_bit_cast(s16x4, __builtin_amdgcn_ds_read_tr16_b64_v4i16((LAS v4i16_t*)p)); }
__device__ __forceinline__ bf16x8 lda16(LAS unsigned char* p) { return *(const LAS bf16x8*)p; }

struct PrepCtx {
    bf16* QKV; const bf16* HALO; const float* DBDA; const float* convw; const float* a_log; const float* dt_bias; bf16* TP; float* VEC;
};
constexpr int PL_RAW = 0, PL_KS = 51200, PL_KK = 67584, PL_LAB = 133120;

__device__ __forceinline__ void prep_unit(const PrepCtx& C, LAS unsigned char* lds, int b, int h, int g) {
    const int tid = tidx(), lane = tid & 63, wid = __builtin_amdgcn_readfirstlane(tid >> 6);
    const int pm = (g == 0) ? 64 + b : b * 8 + (g - 1);
    const size_t row0 = (size_t)pm * 256;
    const bool has_prev = g >= 2, has_next = (g >= 1 && g <= 7);
    LAS bf16* RAW = (LAS bf16*)(lds + PL_RAW);
    LAS float* KK = (LAS float*)(lds + PL_KK);
    LAS float* LBETA = (LAS float*)(lds + PL_LAB); LAS float* LLA = LBETA + 512;
    { const int d = tid >> 8, tl = tid & 255; const float* dr = C.DBDA + (row0 + tl) * 32;
      const float db = dr[d * 8 + h], da = dr[16 + d * 8 + h];
      const float x = da + C.dt_bias[d * 8 + h]; const float sp = x > 15.f ? x : log1pf(__expf(x));
      LBETA[d * 256 + tl] = sigmoidf_(db); LLA[d * 256 + tl] = -__expf(C.a_log[d * 8 + h]) * sp; }
    const int cg = tid & 15, tt0 = tid >> 4;
    for (int j = 0; j < 4; ++j) {
        for (int idx = tid; idx < 66 * 48; idx += 512) {
            const int s = idx / 48, c16 = idx - s * 48; if (j > 0 && s < 2) continue;
            const int tl = 64 * j - 1 + s; const int p = c16 >> 4, cgi = c16 & 15; const int ch = p * 1024 + h * 128 + cgi * 8;
            v4u val = {0u, 0u, 0u, 0u};
            if (tl < 0) { if (has_prev) val = *(const v4u*)(C.HALO + ((size_t)(pm - 1) * 2 + 1) * 3072 + ch); }
            else if (tl > 255) { if (has_next) val = *(const v4u*)(C.HALO + ((size_t)(pm + 1) * 2 + 0) * 3072 + ch); }
            else val = *(const v4u*)(C.QKV + (row0 + tl) * 3072 + ch);
            *(LAS v4u*)(RAW + s * 384 + c16 * 8) = val;
        }
        __syncthreads();
#pragma unroll
        for (int p = 0; p < 3; ++p) {
            const int ch = p * 1024 + h * 128 + cg * 8;
            float cw[3][8];
#pragma unroll
            for (int tp = 0; tp < 3; ++tp) { const f32x4 a = *(const f32x4*)(C.convw + tp * 3072 + ch), bq = *(const f32x4*)(C.convw + tp * 3072 + ch + 4);
#pragma unroll
                for (int e = 0; e < 4; ++e) { cw[tp][e] = a[e]; cw[tp][4 + e] = bq[e]; } }
#pragma unroll
            for (int jj = 0; jj < 2; ++jj) {
                const int tt = tt0 + 32 * jj; float y[8];
#pragma unroll
                for (int e = 0; e < 8; ++e) y[e] = 0.f;
#pragma unroll
                for (int tp = 0; tp < 3; ++tp) { const v4u raw = *(const LAS v4u*)(RAW + (tt + tp) * 384 + p * 128 + cg * 8);
#pragma unroll
                    for (int e = 0; e < 4; ++e) { y[2 * e] += cw[tp][2 * e] * bflo(raw[e]); y[2 * e + 1] += cw[tp][2 * e + 1] * bfhi(raw[e]); } }
#pragma unroll
                for (int e = 0; e < 8; ++e) y[e] = siluf_(y[e]);
                bf16* grow = C.QKV + (row0 + 64 * j + tt) * 3072;
                if (p < 2) {
                    float ss = 0.f;
#pragma unroll
                    for (int e = 0; e < 8; ++e) ss += y[e] * y[e];
                    ss += __shfl_xor(ss, 1); ss += __shfl_xor(ss, 2); ss += __shfl_xor(ss, 4); ss += __shfl_xor(ss, 8);
                    float rn = 1.0f / sqrtf(ss + NORM_EPS); if (p == 0) rn *= 0.088388347648318440f;
                    v2u q0 = {pk2(y[0] * rn, y[1] * rn), pk2(y[2] * rn, y[3] * rn)}, q1 = {pk2(y[4] * rn, y[5] * rn), pk2(y[6] * rn, y[7] * rn)};
                    const int pos0 = 16 * (cg >> 1) + 4 * (cg & 1);
                    bf16* dst = grow + p * 1024 + h * 128 + pos0;
                    *(v2u*)dst = q0; *(v2u*)(dst + 8) = q1;
                    if (p == 1) { LAS unsigned char* ks = lds + PL_KS;
                        *(LAS v2u*)(ks + off_b(tt, 2 * (cg >> 1)) + 8 * (cg & 1)) = q0; *(LAS v2u*)(ks + off_b(tt, 2 * (cg >> 1) + 1) + 8 * (cg & 1)) = q1; }
                } else {
                    v4u w = {pk2(y[0], y[1]), pk2(y[2], y[3]), pk2(y[4], y[5]), pk2(y[6], y[7])};
                    *(v4u*)(grow + 2048 + h * 128 + cg * 8) = w;
                }
            }
        }
        __syncthreads();
        if (wid < 4) {
            const int mt = wid >> 1, nt = wid & 1, r = lane & 31, hh = lane >> 5; LAS unsigned char* ksb = lds + PL_KS;
            f32x16 acc = {};
#pragma unroll
            for (int sg = 0; sg < 8; ++sg) { const bf16x8 a = lda16(ksb + off_b(32 * mt + r, 2 * sg + hh)), bb = lda16(ksb + off_b(32 * nt + r, 2 * sg + hh));
                acc = __builtin_amdgcn_mfma_f32_32x32x16_bf16(a, bb, acc, 0, 0, 0); }
#pragma unroll
            for (int rho = 0; rho < 16; ++rho) KK[(j * 64 + 32 * mt + crow(rho, hh)) * 64 + 32 * nt + r] = acc[rho];
        } else if (tid - 256 < 96 && j < 3) {
            const int i2 = tid - 256; const int s = i2 / 48, c16 = i2 - s * 48;
            const v4u val = *(const LAS v4u*)(RAW + (64 + s) * 384 + c16 * 8); *(LAS v4u*)(RAW + s * 384 + c16 * 8) = val;
        }
        __syncthreads();
    }
    {
        const int jw = wid >> 1, dir = wid & 1;
        const float beta = LBETA[dir * 256 + 64 * jw + lane], la = LLA[dir * 256 + 64 * jw + lane];
        float gam = la;
#pragma unroll
        for (int o = 1; o < 64; o <<= 1) { const float up = __shfl_up(gam, o), dn = __shfl_down(gam, o); if (dir == 0) { if (lane >= o) gam += up; } else { if (lane + o < 64) gam += dn; } }
        const float rsv = dir == 0 ? beta : 1.f, csv = dir == 0 ? 1.f : beta;
        float W[64];
        const LAS float* kkb = KK + jw * 4096;
#pragma unroll
        for (int i = 0; i < 64; ++i) {
            float s = 0.f;
#pragma unroll
            for (int q4 = 0; q4 < (i + 3) / 4; ++q4) { const f32x4 kv = *(const LAS f32x4*)(kkb + i * 64 + 4 * q4);
#pragma unroll
                for (int e = 0; e < 4; ++e) if (4 * q4 + e < i) s += kv[e] * W[4 * q4 + e]; }
            const float rs_i = readlane_f(rsv, i), cs_i = readlane_f(csv, i);
            const float yv = (lane == i ? 1.f : 0.f) - rs_i * s;
            W[i] = cs_i * yv;
        }
        const int cidx = (g == 0) ? jw : 4 * g + jw;
        const size_t cd = ((size_t)(b * 8 + h) * NCH + cidx) * 2 + dir;
        bf16* tp = C.TP + cd * 4096; float* vec = C.VEC + cd * 256;
        if (dir == 0) {
            const int pc = swz16(lane & 15) + (lane & 48);
#pragma unroll
            for (int i = 0; i < 64; ++i) { const float gi = readlane_f(gam, i);
                const float val = (i >= lane) ? fast_exp(fminf(gi - gam, 0.f)) * W[i] * beta : 0.f;
                tp[i * 64 + pc] = (bf16)f2bf(val); }
        } else {
            float vals[64];
#pragma unroll
            for (int i = 0; i < 64; ++i) { const float gi = readlane_f(gam, i); vals[i] = (i >= lane) ? fast_exp(fminf(gam - gi, 0.f)) * W[i] : 0.f; }
#pragma unroll
            for (int k8 = 0; k8 < 8; ++k8) { v4u w;
#pragma unroll
                for (int e = 0; e < 4; ++e) { const int p0 = 8 * k8 + 2 * e, p1 = p0 + 1; w[e] = pk2(vals[(p0 & 48) + swz16(p0 & 15)], vals[(p1 & 48) + swz16(p1 & 15)]); }
                *(v4u*)(tp + lane * 64 + 8 * k8) = w; }
        }
        const float gl0 = readlane_f(gam, 63), gl1 = readlane_f(gam, 0); const float gl = dir == 0 ? gl0 : gl1;
        vec[lane] = fast_exp(gam); vec[64 + lane] = fast_exp(gl - gam); vec[128 + lane] = gam; if (lane == 0) vec[192] = fast_exp(gl);
    }
    __syncthreads();
}

struct ScanCtx { const bf16* QKV; const bf16* TP; const float* VEC; bf16* O0; bf16* O1; };
constexpr int SB_KQ = 0, SB_TP = 32768, SB_P = 40960, SB_V = 49152, SB_STRIDE = 65536, SL_VEC = 131072;

__device__ __forceinline__ int scan_cidx(int dir, int n) { return dir == 0 ? n : (n < 4 ? 3 - n : 39 - n); }

__device__ __forceinline__ void scan_fill(const ScanCtx& C, LAS unsigned char* lds, int b, int h, int dir, int cidx, int buf) {
    const int ht = tidx() - 256, lane = ht & 63, hw = __builtin_amdgcn_readfirstlane(ht >> 6);
    const bool has_out = cidx >= 4;
    const size_t row0 = cidx < 4 ? (size_t)M_LAT + b * 256 + 64 * cidx : (size_t)b * 2048 + 64 * (cidx - 4);
    const size_t cd = ((size_t)(b * 8 + h) * NCH + cidx) * 2 + dir;
    LAS unsigned char* B = lds + buf * SB_STRIDE;
    const bf16* qkv = C.QKV + row0 * 3072 + h * 128;
    v4u kq[8], tpv[2], vv[4]; v4u vecv = {0u, 0u, 0u, 0u};
#pragma unroll
    for (int i = 0; i < 8; ++i) { const int idx = ht + 256 * i, row = idx >> 4, ch = idx & 15;
        if (row < 64) kq[i] = *(const v4u*)(qkv + (size_t)row * 3072 + 1024 + ch * 8);
        else if (has_out) kq[i] = *(const v4u*)(qkv + (size_t)(row - 64) * 3072 + ch * 8);
        else kq[i] = (v4u){0u, 0u, 0u, 0u}; }
#pragma unroll
    for (int i = 0; i < 2; ++i) { const int idx = ht + 256 * i; tpv[i] = *(const v4u*)(C.TP + cd * 4096 + (size_t)idx * 8); }
#pragma unroll
    for (int i = 0; i < 4; ++i) { const int idx = ht + 256 * i, row = idx >> 4, ch = idx & 15; vv[i] = *(const v4u*)(qkv + (size_t)row * 3072 + 2048 + ch * 8); }
    if (ht < 64) vecv = *(const v4u*)(C.VEC + cd * 256 + ht * 4);
    const int r = lane & 31, hh = lane >> 5;
    int mt = 0, nt = 0; if (hw == 1) { mt = dir == 0 ? 1 : 0; nt = dir == 0 ? 0 : 1; } else if (hw == 2) { mt = 1; nt = 1; }
    const bool do_p = has_out && hw < 3;
    f32x16 acc = {};
    if (do_p) {
        bf16x8 kf[8], qf[8];
#pragma unroll
        for (int sg = 0; sg < 8; ++sg) { kf[sg] = *(const bf16x8*)(qkv + (size_t)(32 * nt + r) * 3072 + 1024 + 16 * sg + 8 * hh); qf[sg] = *(const bf16x8*)(qkv + (size_t)(32 * mt + r) * 3072 + 16 * sg + 8 * hh); }
#pragma unroll
        for (int sg = 0; sg < 8; ++sg) acc = __builtin_amdgcn_mfma_f32_32x32x16_bf16(kf[sg], qf[sg], acc, 0, 0, 0);
    }
#pragma unroll
    for (int i = 0; i < 8; ++i) { const int idx = ht + 256 * i, row = idx >> 4, ch = idx & 15; *(LAS v4u*)(B + SB_KQ + off_b(row, ch)) = kq[i]; }
#pragma unroll
    for (int i = 0; i < 2; ++i) { const int idx = ht + 256 * i, row = idx >> 3, ch = idx & 7; *(LAS v4u*)(B + SB_TP + off_t(row, ch)) = tpv[i]; }
#pragma unroll
    for (int i = 0; i < 4; ++i) { const int idx = ht + 256 * i, row = idx >> 4, ch = idx & 15; *(LAS v4u*)(B + SB_V + off_b(row, ch)) = vv[i]; }
    if (ht < 64) *(LAS v4u*)(lds + SL_VEC + buf * 1024 + ht * 16) = vecv;
    if (do_p) {
        const float* gv = C.VEC + cd * 256 + 128;
        const int a = 32 * mt + r; const float ga = gv[a];
        float val[16];
#pragma unroll
        for (int g4 = 0; g4 < 4; ++g4) { const f32x4 gb = *(const f32x4*)(gv + 32 * nt + 8 * g4 + 4 * hh);
#pragma unroll
            for (int e = 0; e < 4; ++e) { const int bb = 32 * nt + 8 * g4 + 4 * hh + e; const bool ok = dir == 0 ? (bb <= a) : (bb >= a);
                val[4 * g4 + e] = ok ? fast_exp(fminf(ga - gb[e], 0.f)) * acc[4 * g4 + e] : 0.f; } }
#pragma unroll
        for (int s = 0; s < 2; ++s) { v4u w = {cvtpk(val[8 * s], val[8 * s + 1]), cvtpk(val[8 * s + 2], val[8 * s + 3]), cvtpk(val[8 * s + 4], val[8 * s + 5]), cvtpk(val[8 * s + 6], val[8 * s + 7])};
            *(LAS v4u*)(B + SB_P + off_t(a, 4 * nt + 2 * s + hh)) = w; }
    }
}

#define GDN_PACK8(X, base) ((v4u){cvtpk(X[(base)], X[(base) + 1]), cvtpk(X[(base) + 2], X[(base) + 3]), cvtpk(X[(base) + 4], X[(base) + 5]), cvtpk(X[(base) + 6], X[(base) + 7])})

__device__ __forceinline__ void scan_step(const ScanCtx& C, LAS unsigned char* lds, int b, int h, int dir, int cidx, int buf, f32x16 (&Sacc)[4], v4u (&SBp)[4][2]) {
    const int lane = tidx() & 63, w = __builtin_amdgcn_readfirstlane(tidx() >> 6);
    const int r = lane & 31, hh = lane >> 5, blk = (lane >> 4) & 1, q4 = (lane & 15) >> 2, p4 = lane & 3;
    const bool has_out = cidx >= 4;
    LAS unsigned char* B = lds + buf * SB_STRIDE;
    const LAS float* vec = (const LAS float*)(lds + SL_VEC + buf * 1024);
    v4u RB[4];
#pragma unroll
    for (int mt = 0; mt < 2; ++mt) { f32x16 acc = {};
#pragma unroll
        for (int t = 0; t < 4; ++t)
#pragma unroll
            for (int s = 0; s < 2; ++s) acc = __builtin_amdgcn_mfma_f32_32x32x16_bf16(lda16(B + SB_KQ + off_b(32 * mt + r, 4 * t + 2 * s + hh)), __builtin_bit_cast(bf16x8, SBp[t][s]), acc, 0, 0, 0);
        float rr[16];
#pragma unroll
        for (int g4 = 0; g4 < 4; ++g4) { const int tb = 32 * mt + 8 * g4 + 4 * hh;
            const s16x4 v4 = vtr(B + SB_V + off_b(tb + q4, 4 * w + 2 * blk + (p4 >> 1)) + 8 * (p4 & 1));
            const f32x4 eg = *(const LAS f32x4*)(vec + tb);
#pragma unroll
            for (int e = 0; e < 4; ++e) rr[4 * g4 + e] = bf2f((unsigned short)v4[e]) - eg[e] * acc[4 * g4 + e]; }
        RB[2 * mt] = GDN_PACK8(rr, 0); RB[2 * mt + 1] = GDN_PACK8(rr, 8); }
    f32x16 dl[2];
#pragma unroll
    for (int mt = 0; mt < 2; ++mt) { f32x16 acc = {};
#pragma unroll
        for (int s = 0; s < 4; ++s) acc = __builtin_amdgcn_mfma_f32_32x32x16_bf16(lda16(B + SB_TP + off_t(32 * mt + r, 2 * s + hh)), __builtin_bit_cast(bf16x8, RB[s]), acc, 0, 0, 0);
        dl[mt] = acc; }
    v4u DB[4], D2B[4];
#pragma unroll
    for (int mt = 0; mt < 2; ++mt) { float d2[16], d1[16];
#pragma unroll
        for (int g4 = 0; g4 < 4; ++g4) { const f32x4 egl = *(const LAS f32x4*)(vec + 64 + 32 * mt + 8 * g4 + 4 * hh);
#pragma unroll
            for (int e = 0; e < 4; ++e) { d1[4 * g4 + e] = dl[mt][4 * g4 + e]; d2[4 * g4 + e] = egl[e] * dl[mt][4 * g4 + e]; } }
        DB[2 * mt] = GDN_PACK8(d1, 0); DB[2 * mt + 1] = GDN_PACK8(d1, 8); D2B[2 * mt] = GDN_PACK8(d2, 0); D2B[2 * mt + 1] = GDN_PACK8(d2, 8); }
    if (has_out) {
        const size_t m0 = (size_t)b * 2048 + 64 * (cidx - 4);
#pragma unroll
        for (int mt = 0; mt < 2; ++mt) { f32x16 acc = {};
#pragma unroll
            for (int t = 0; t < 4; ++t)
#pragma unroll
                for (int s = 0; s < 2; ++s) acc = __builtin_amdgcn_mfma_f32_32x32x16_bf16(lda16(B + SB_KQ + off_b(64 + 32 * mt + r, 4 * t + 2 * s + hh)), __builtin_bit_cast(bf16x8, SBp[t][s]), acc, 0, 0, 0);
#pragma unroll
            for (int g4 = 0; g4 < 4; ++g4) { const f32x4 eg = *(const LAS f32x4*)(vec + 32 * mt + 8 * g4 + 4 * hh);
#pragma unroll
                for (int e = 0; e < 4; ++e) acc[4 * g4 + e] *= eg[e]; }
#pragma unroll
            for (int s = 0; s < 4; ++s) acc = __builtin_amdgcn_mfma_f32_32x32x16_bf16(lda16(B + SB_P + off_t(32 * mt + r, 2 * s + hh)), __builtin_bit_cast(bf16x8, DB[s]), acc, 0, 0, 0);
#pragma unroll
            for (int rho = 0; rho < 16; ++rho) { const size_t m = m0 + 32 * mt + crow(rho, hh); const bf16 ov = (bf16)f2bf(acc[rho]);

#ifdef SWAP_O
                if (dir == 1) C.O0[m * 2048 + h * 128 + 32 * w + r] = ov; else C.O1[m * 1024 + h * 128 + 32 * w + r] = ov; }
#else
                if (dir == 0) C.O0[m * 2048 + h * 128 + 32 * w + r] = ov; else C.O1[m * 1024 + h * 128 + 32 * w + r] = ov; }
#endif

        }
    }
    const float glast = vec[192];
#pragma unroll
    for (int t = 0; t < 4; ++t) { f32x16 acc = Sacc[t];
#pragma unroll
        for (int rho = 0; rho < 16; ++rho) acc[rho] *= glast;
#pragma unroll
        for (int s = 0; s < 4; ++s) {
            const int pp = (p4 == 1) ? 2 : (p4 == 2 ? 1 : p4);
            const s16x4 lo = vtr(B + SB_KQ + off_b(16 * s + 4 * hh + q4, 4 * t + 2 * blk + (pp >> 1)) + 8 * (pp & 1));
            const s16x4 hi4 = vtr(B + SB_KQ + off_b(16 * s + 8 + 4 * hh + q4, 4 * t + 2 * blk + (pp >> 1)) + 8 * (pp & 1));
            const bf16x8 a = {lo[0], lo[1], lo[2], lo[3], hi4[0], hi4[1], hi4[2], hi4[3]};
            acc = __builtin_amdgcn_mfma_f32_32x32x16_bf16(a, __builtin_bit_cast(bf16x8, D2B[s]), acc, 0, 0, 0); }
        Sacc[t] = acc;
        SBp[t][0] = GDN_PACK8(acc, 0); SBp[t][1] = GDN_PACK8(acc, 8); }
}
}
constexpr int NWAVES = 8;
#ifndef MK_LAST_PHASE
#define MK_LAST_PHASE 99
#endif
enum { I_X = 0, I_C, I_CTX, I_CCTX, I_WMOD, I_BMOD, I_WIN, I_QNW, I_KNW, I_CONVW, I_ALOG, I_DTB, I_GNW, I_WPA, I_WPD, I_WOUT, I_WUP, I_FCW, I_FCB, I_WDN, I_FNW, N_IN };
struct Args { const float* in[N_IN]; float* out; unsigned char* ws; int ph_lo, ph_hi; };

__device__ __forceinline__ void transpose_item(const float* W, int N, bf16* WT, int ldw, int koff, int drow0, LAS float* scr, int kb, int nb, int lane) {
    const int k0 = 64 * kb, n0 = 32 * nb;
#pragma unroll 8
    for (int i = 0; i < 32; ++i) { const int kk = 2 * i + (lane >> 5); scr[kk * 33 + (lane & 31)] = W[(size_t)(k0 + kk) * N + n0 + (lane & 31)]; }
    LDS_WAIT(); asm volatile("" ::: "memory");
    const int c = lane & 7;
#pragma unroll
    for (int j = 0; j < 4; ++j) { const int n = (lane >> 3) + 8 * j; const LAS float* s = scr + (8 * c) * 33 + n;
        v4u o; o.x = pk2(s[0 * 33], s[1 * 33]); o.y = pk2(s[2 * 33], s[3 * 33]); o.z = pk2(s[4 * 33], s[5 * 33]); o.w = pk2(s[6 * 33], s[7 * 33]);
        *(v4u*)(WT + (size_t)(drow0 + n) * ldw + koff + k0 + 8 * c) = o; }
    LDS_WAIT(); asm volatile("" ::: "memory");
}
__device__ __forceinline__ void rms_row(const float* xrow, int lane, f32x4 (&v)[4], float& rstd) {
    const f32x4* xr = (const f32x4*)xrow + lane; float s = 0.f;
#pragma unroll
    for (int j = 0; j < 4; ++j) { v[j] = xr[64 * j]; s += (v[j].x * v[j].x + v[j].y * v[j].y) + (v[j].z * v[j].z + v[j].w * v[j].w); }
    rstd = 1.0f / sqrtf(wave_sum(s) * (1.0f / 1024.0f) + NORM_EPS);
}
__device__ __forceinline__ void norm_mod_row_bf16(const float* xrow, const float* shift, const float* scale, bf16* orow, int lane) {
    f32x4 v[4]; float rstd; rms_row(xrow, lane, v, rstd);
    unsigned long long* o8 = (unsigned long long*)orow + lane;
#pragma unroll
    for (int j = 0; j < 4; ++j) { const f32x4 sh = ((const f32x4*)shift)[lane + 64 * j], sc = ((const f32x4*)scale)[lane + 64 * j];
        const float a = v[j].x * rstd * (1.f + sc.x) + sh.x, b = v[j].y * rstd * (1.f + sc.y) + sh.y, c = v[j].z * rstd * (1.f + sc.z) + sh.z, d = v[j].w * rstd * (1.f + sc.w) + sh.w;
        o8[64 * j] = (unsigned long long)pk2(a, b) | ((unsigned long long)pk2(c, d) << 32); }
}

template <class F> struct EpiRow8 {
    static constexpr bool PERM = true, AFTER_DRAIN = false; F f;
    __device__ __forceinline__ void operator()(const f32x4 (&acc)[2][2][4][2], const pg8::Unit& u, int wr, int wc, int fr, int fq) const {
#pragma unroll
        for (int ai = 0; ai < 2; ++ai)
#pragma unroll
            for (int m = 0; m < 4; ++m) { const int rt = ai * 128 + wr * 64 + m * 16 + fr;
#pragma unroll
                for (int bj = 0; bj < 2; ++bj) f(u, rt, bj * 128 + wc * 32 + 8 * fq, acc[ai][bj][m][0], acc[ai][bj][m][1]); }
    }
};
__device__ __forceinline__ v4u pack8(f32x4 a, f32x4 b) { return (v4u){cvtpk(a[0], a[1]), cvtpk(a[2], a[3]), cvtpk(b[0], b[1]), cvtpk(b[2], b[3])}; }
__device__ __forceinline__ void unpack8(v4u w, f32x4& a, f32x4& b) { a = (f32x4){bflo(w[0]), bfhi(w[0]), bflo(w[1]), bfhi(w[1])}; b = (f32x4){bflo(w[2]), bfhi(w[2]), bflo(w[3]), bfhi(w[3])}; }

struct InProjF { bf16 *K, *V, *QKV, *HALO, *A2; float* DBDA;
    __device__ __forceinline__ void operator()(const pg8::Unit& u, int rt, int ct, f32x4 v0, f32x4 v1) const {
        const int pn = u.pn; const size_t row = (size_t)u.pm * 256 + rt;
        if (pn == 18) { if (ct < 32) { float* d = DBDA + row * 32 + ct; *(f32x4*)d = v0; *(f32x4*)(d + 4) = v1; } return; }
        const v4u w = pack8(v0, v1);
        if (pn < 2) { const size_t kvrow = u.pm < 64 ? (size_t)(u.pm >> 3) * KVLEN + CTXL + (u.pm & 7) * 256 + rt : (size_t)(u.pm - 64) * KVLEN + rt;
            *(v4u*)((pn == 0 ? K : V) + kvrow * 256 + ct) = w; }
        else if (pn < 14) { const int c = (pn - 2) * 256 + ct; *(v4u*)(QKV + row * 3072 + c) = w;
            if (rt == 0 || rt == 255) *(v4u*)(HALO + ((size_t)u.pm * 2 + (rt == 255 ? 1 : 0)) * 3072 + c) = w; }
        else *(v4u*)(A2 + row * 2048 + (pn - 14) * 256 + ct) = w;
    }
};
struct P2Order {
    pg8::StaticOrder so; int G, c;
    __device__ __forceinline__ void init(int G_, int c_) { so.init(64, WIN_P2_TILES, G_, c_); G = G_; c = c_; }
    __device__ __forceinline__ bool next(int i, pg8::Unit& u) const {
        const int L = i * G + c; if (L < 64 * WIN_P2_TILES) return so.next(i, u);
        const int j = L - 64 * WIN_P2_TILES; if (j >= 8 * 15) return false;
        u.pm = 64 + (j & 7); const int q = j >> 3; u.pn = q < 14 ? q : 18; return true; }
    __device__ __forceinline__ void a_ready(const pg8::Unit&) const {}
    __device__ __forceinline__ void done(const pg8::Unit&) const {}
};
struct GateF { bf16 *ZS, *GATES;
    __device__ __forceinline__ void operator()(const pg8::Unit& u, int rt, int ct, f32x4 v0, f32x4 v1) const {
        const size_t row = (size_t)u.pm * 256 + rt;
#pragma unroll
        for (int e = 0; e < 4; ++e) { if (u.pn < 4) { v0[e] = siluf_(v0[e]); v1[e] = siluf_(v1[e]); } else { v0[e] = sigmoidf_(v0[e]); v1[e] = sigmoidf_(v1[e]); } }
        const v4u w = pack8(v0, v1);
        if (u.pn < 4) *(v4u*)(ZS + row * 1024 + u.pn * 256 + ct) = w; else *(v4u*)(GATES + row * 2048 + (u.pn - 4) * 256 + ct) = w;
    }
};
struct Merge1F { const bf16* GATES; bf16* Y1;
    __device__ __forceinline__ void operator()(const pg8::Unit& u, int rt, int ct, f32x4 v0, f32x4 v1) const {
        const size_t row = (size_t)u.pm * 256 + rt; const int col = u.pn * 256 + ct;
        f32x4 g0, g1; unpack8(*(const v4u*)(GATES + row * 2048 + col), g0, g1);
        *(v4u*)(Y1 + row * 1024 + col) = pack8(v0 * g0, v1 * g1); }
};
struct Merge2F { const bf16* GATES; const bf16* Y1; bf16* Y;
    __device__ __forceinline__ void operator()(const pg8::Unit& u, int rt, int ct, f32x4 v0, f32x4 v1) const {
        const size_t row = (size_t)u.pm * 256 + rt; const int col = u.pn * 256 + ct;
        f32x4 g0, g1, a0, a1; unpack8(*(const v4u*)(GATES + row * 2048 + 1024 + col), g0, g1); unpack8(*(const v4u*)(Y1 + row * 1024 + col), a0, a1);

#ifdef ZERO_GDN
        v0 = v0 * 0.f; v1 = v1 * 0.f;
#endif
#ifdef ZERO_ATTN
        a0 = a0 * 0.f; a1 = a1 * 0.f;
#endif
        *(v4u*)(Y + row * 1024 + col) = pack8(a0 + v0 * g0, a1 + v1 * g1); }
};
struct ResidF { const float* base; const float* mod; int goff; float* out;
    __device__ __forceinline__ void operator()(const pg8::Unit& u, int rt, int ct, f32x4 v0, f32x4 v1) const {
        const size_t row = (size_t)u.pm * 256 + rt; const int col = u.pn * 256 + ct; const int b = u.pm >> 3;
        const float* g = mod + (size_t)b * 6144 + goff + col; const f32x4 g0 = *(const f32x4*)g, g1 = *(const f32x4*)(g + 4);
        const float* bp = base + row * 1024 + col; const f32x4 b0 = *(const f32x4*)bp, b1 = *(const f32x4*)(bp + 4);
        float* o = out + row * 1024 + col; *(f32x4*)o = b0 + g0 * v0; *(f32x4*)(o + 4) = b1 + g1 * v1; }
};
struct UpF { bf16* U;
    __device__ __forceinline__ void operator()(const pg8::Unit& u, int rt, int ct, f32x4 v0, f32x4 v1) const {
        const size_t row = (size_t)u.pm * 256 + rt; *(v4u*)(U + row * 3072 + u.pn * 256 + ct) = pack8(v0, v1); }
};

__device__ __forceinline__ float dpp_f(float old, float src, int ctrl_sel) {
    const int o = __builtin_bit_cast(int, old), s = __builtin_bit_cast(int, src); int r;
    if (ctrl_sel == 0) r = __builtin_amdgcn_update_dpp(o, s, 0x111, 0xF, 0xF, false);
    else if (ctrl_sel == 1) r = __builtin_amdgcn_update_dpp(o, s, 0x101, 0xF, 0xF, false);
    else if (ctrl_sel == 2) r = __builtin_amdgcn_update_dpp(o, s, 0x121, 0xF, 0xF, false);
    else r = __builtin_amdgcn_update_dpp(o, s, 0x12F, 0xF, 0xF, false);
    return __builtin_bit_cast(float, r);
}
struct EpiFfnUp {
    static constexpr bool PERM = true, AFTER_DRAIN = false;
    bf16* ACT; float* SIDE; const float* cw; const float* cb; LAS float* xch;
    __device__ __forceinline__ void operator()(const f32x4 (&acc)[2][2][4][2], const pg8::Unit& u, int wr, int wc, int fr, int fq) const {
        const int wv = wr * 4 + wc, ow = (wr ^ 1) * 4 + wc;
        if (fr == 0) {
#pragma unroll
            for (int ai = 0; ai < 2; ++ai)
#pragma unroll
                for (int bj = 0; bj < 2; ++bj)
#pragma unroll
                    for (int n = 0; n < 2; ++n) *(LAS f32x4*)(xch + (wv * 4 + 2 * ai) * 64 + bj * 32 + fq * 8 + n * 4) = acc[ai][bj][0][n];
        }
        if (fr == 15) {
#pragma unroll
            for (int ai = 0; ai < 2; ++ai)
#pragma unroll
                for (int bj = 0; bj < 2; ++bj)
#pragma unroll
                    for (int n = 0; n < 2; ++n) *(LAS f32x4*)(xch + (wv * 4 + 2 * ai + 1) * 64 + bj * 32 + fq * 8 + n * 4) = acc[ai][bj][3][n];
        }
        { const bool lo = (wr == 0 && fr < 2), hi = (wr == 1 && fr >= 14);
          if (lo || hi) { const int k = lo ? fr : fr - 12; float* sp = SIDE + ((size_t)u.pm * 4 + k) * 5632 + u.pn * 256 + wc * 32 + fq * 8;
#pragma unroll
              for (int bj = 0; bj < 2; ++bj)
#pragma unroll
                  for (int n = 0; n < 2; ++n) *(f32x4*)(sp + bj * 128 + n * 4) = lo ? acc[0][bj][0][n] : acc[1][bj][3][n]; } }
        asm volatile("s_waitcnt lgkmcnt(0)" ::: "memory"); __builtin_amdgcn_s_barrier(); asm volatile("" ::: "memory");
        const int ch0 = u.pn * 128 + wc * 32 + fq * 8;
#pragma unroll
        for (int ai = 0; ai < 2; ++ai) {
            const bool hasP = !(wr == 0 && ai == 0), hasN = !(wr == 1 && ai == 1);
            const int pslot = ow * 4 + (wr == 0 ? 1 : (ai == 0 ? 1 : 3)), nslot = ow * 4 + (wr == 0 ? (ai == 0 ? 0 : 2) : 2);
#pragma unroll
            for (int m = 0; m < 4; ++m) {
                float outv[8];
#pragma unroll
                for (int n = 0; n < 2; ++n) {
                    f32x4 pB[2], nB[2];
#pragma unroll
                    for (int bj = 0; bj < 2; ++bj) {
                        pB[bj] = (f32x4){0.f, 0.f, 0.f, 0.f}; nB[bj] = (f32x4){0.f, 0.f, 0.f, 0.f};
                        if (m == 0 && hasP) pB[bj] = *(const LAS f32x4*)(xch + pslot * 64 + bj * 32 + fq * 8 + n * 4);
                        if (m == 3 && hasN) nB[bj] = *(const LAS f32x4*)(xch + nslot * 64 + bj * 32 + fq * 8 + n * 4);
                    }
#pragma unroll
                    for (int e = 0; e < 4; ++e) {
                        const int c = ch0 + 4 * n + e; float uu[2];
#pragma unroll
                        for (int bj = 0; bj < 2; ++bj) {
                            const float cur = acc[ai][bj][m][n][e];
                            const float po = (m > 0) ? dpp_f(0.f, acc[ai][bj][m > 0 ? m - 1 : 0][n][e], 2) : pB[bj][e];
                            const float no = (m < 3) ? dpp_f(0.f, acc[ai][bj][m < 3 ? m + 1 : 3][n][e], 3) : nB[bj][e];
                            const float pv = dpp_f(po, cur, 0), nv = dpp_f(no, cur, 1);
                            const float* w = cw + bj * 2816 + c;
                            uu[bj] = cb[bj * 2816 + c] + w[0] * pv + w[5632] * cur + w[2 * 5632] * nv;
                        }
                        outv[4 * n + e] = siluf_(uu[0]) * uu[1];
                    }
                }
                const size_t row = (size_t)u.pm * 256 + ai * 128 + wr * 64 + m * 16 + fr;
                *(v4u*)(ACT + row * 2816 + ch0) = (v4u){cvtpk(outv[0], outv[1]), cvtpk(outv[2], outv[3]), cvtpk(outv[4], outv[5]), cvtpk(outv[6], outv[7])};
            }
        }
    }
};
__device__ __forceinline__ void ffn_fixup(bf16* ACT, const float* SIDE, const float* cw, const float* cb, int pm, int tid) {
    for (int i = tid; i < 2 * 2816; i += 512) {
        const int which = i / 2816, c = i - which * 2816;
        const int col = (c >> 7) * 256 + (c & 127);
        const float* S0 = SIDE + (size_t)pm * 4 * 5632;
        float pg, pv, cg, cv, ng, nv;
        if (which == 0) { const bool hp = (pm & 7) != 0; const float* P = SIDE + ((size_t)(pm - 1) * 4 + 3) * 5632;
            pg = hp ? P[col] : 0.f; pv = hp ? P[col + 128] : 0.f; cg = S0[col]; cv = S0[col + 128]; ng = S0[5632 + col]; nv = S0[5632 + col + 128]; }
        else { const bool hn = (pm & 7) != 7; const float* N = SIDE + ((size_t)(pm + 1) * 4 + 0) * 5632;
            pg = S0[2 * 5632 + col]; pv = S0[2 * 5632 + col + 128]; cg = S0[3 * 5632 + col]; cv = S0[3 * 5632 + col + 128]; ng = hn ? N[col] : 0.f; nv = hn ? N[col + 128] : 0.f; }
        const float ug = cb[c] + cw[c] * pg + cw[5632 + c] * cg + cw[2 * 5632 + c] * ng;
        const float uv = cb[2816 + c] + cw[2816 + c] * pv + cw[5632 + 2816 + c] * cv + cw[2 * 5632 + 2816 + c] * nv;
        ACT[((size_t)pm * 256 + (which ? 255 : 0)) * 2816 + c] = (bf16)f2bf(siluf_(ug) * uv);
    }
}

#define GRID_BAR() xcd_barrier(bar)
__global__ void __launch_bounds__(NWAVES * 64, 2) fwd_kernel(Args args) {
    extern __shared__ __attribute__((aligned(16))) unsigned char lds_raw[];
    LAS unsigned char* lds = (LAS unsigned char*)lds_raw;
    volatile LAS unsigned* MISC = (volatile LAS unsigned*)(lds + MISC_OFF);
    const int tid0 = tidx(), wave = __builtin_amdgcn_readfirstlane(tid0 >> 6);
#define PH_LOCALS const int tid = tidx(), lane = tid & 63; (void)lane; (void)tid
    const int G = gridDim.x, bx = blockIdx.x;
    const int vcu = (G % 8 == 0) ? (bx % 8) * (G / 8) + bx / 8 : bx;
    const int gw = vcu * NWAVES + wave, NGW = G * NWAVES;
    unsigned char* ws = args.ws; unsigned char* dob = (unsigned char*)args.out;
    gu32* ctl = (gu32*)(ws + WS_CTL);
    const float* x = args.in[I_X];
#define MOD ((float*)(ws + WS_MOD))
#define ROPE ((float*)(ws + WS_ROPE))
#define HALO ((bf16*)(ws + WS_HALO))
#define DBDA ((float*)(ws + WS_DBDA))
#define WinT ((bf16*)(ws + WS_WIN))
#define KB ((bf16*)(ws + WS_K))
#define VB ((bf16*)(ws + WS_V))
#define A2 ((bf16*)(ws + WS_A2))
#define QKV ((bf16*)(ws + WS_QKV))
#define TP ((bf16*)(ws + WS_TP))
#define VEC ((float*)(ws + WS_VEC))
#define ZS ((bf16*)(ws + WS_ZS))
#define GATES ((bf16*)(ws + WS_GATES))
#define WmT ((bf16*)(ws + WS_WM))
#define WoT ((bf16*)(ws + WS_WO))
#define WupT ((bf16*)(ws + WS_WUP))
#define WdT ((bf16*)(ws + WS_WDN))
#define Y ((bf16*)(ws + WS_Y))
#define H2 ((bf16*)(ws + WS_H2))
#define ACT ((bf16*)(ws + WS_ACT))
#define SIDE ((float*)(ws + WS_SIDE))
#define XN ((bf16*)(dob + DO_XN))
#define O1 ((bf16*)(dob + DO_O1))
#define Y1 ((bf16*)dob)
#define X1 ((float*)dob)
    for (int u = tid0; u < (LDS_BYTES - LDSCTL_OFF) / 4; u += NWAVES * 64) ((LAS unsigned*)(lds + LDSCTL_OFF))[u] = 0u;
    __syncthreads();
    XcdBarrier bar = xcd_barrier_post((unsigned*)(ctl + CW_BAR), MISC + 8);
    const int lo = args.ph_lo, hi = args.ph_hi;
#ifndef PH_MASK
#define PH_MASK 0x3fff
#endif
#define IN(k) ((((PH_MASK) >> (k)) & 1) && lo <= (k) && (k) < hi)
#define SEAM(k) do { if (IN(k) && IN((k) + 1)) GRID_BAR(); DUMP_CHECK(k); } while (0)
#ifdef DUMP_PHASE
#define DUMP_CHECK(k) do { if ((k) == DUMP_PHASE) { float* dst = args.out; \
      GRID_BAR(); for (long i = (long)vcu * 512 + tid0; i < (long)M_LAT * 1024; i += (long)G * 512) { dst[i] = DUMP_EXPR(i); } return; } } while (0)
#else
#define DUMP_CHECK(k) do {} while (0)
#endif

    if (IN(0)) { PH_LOCALS;
        if (bx < 192) {
            LAS float* sc = (LAS float*)lds; LAS float* part = (LAS float*)(lds + 40960);
            for (int i = tid; i < 9 * 1024; i += 512) { const int r = i >> 10, k = i & 1023; const float v = r < 8 ? args.in[I_C][r * 1024 + k] : args.in[I_CCTX][k]; sc[i] = siluf_(v); }
            __syncthreads();
            for (int item = bx; item < 192; item += G) {
                const int n0 = item * 32, col = lane & 31, kh = lane >> 5, kbase = wave * 128 + kh * 64;
                float acc[9];
#pragma unroll
                for (int r = 0; r < 9; ++r) acc[r] = 0.f;
                const float* wp = args.in[I_WMOD] + (size_t)kbase * 6144 + n0 + col;
#pragma unroll 8
                for (int kk = 0; kk < 64; ++kk) { const float w = wp[(size_t)kk * 6144];
#pragma unroll
                    for (int r = 0; r < 9; ++r) acc[r] += sc[r * 1024 + kbase + kk] * w; }
#pragma unroll
                for (int r = 0; r < 9; ++r) part[((wave * 2 + kh) * 9 + r) * 32 + col] = acc[r];
                __syncthreads();
                if (tid < 288) { const int r = tid >> 5, c2 = tid & 31; float s = args.in[I_BMOD][n0 + c2];
#pragma unroll
                    for (int p = 0; p < 16; ++p) s += part[(p * 9 + r) * 32 + c2];
                    MOD[r * 6144 + n0 + c2] = s; }
                __syncthreads();
            }
        }
        __syncthreads();
        {
            LAS float* scr = (LAS float*)(lds + wave * 16384);
            for (int it = gw; it < 16 * 241; it += NGW) { const int kb = it / 241, nb = it - kb * 241; const int n0 = nb * 32;
                const int drow = n0 < 3584 ? n0 : (n0 < 3616 ? 4608 + (n0 - 3584) : (n0 < 4640 ? 3584 + (n0 - 3616) : 4864 + (n0 - 4640)));
                transpose_item(args.in[I_WIN], 7712, WinT, 1024, 0, drow, scr, kb, nb, lane); }
            const int gt = vcu * 512 + tid;
            for (int i = gt; i < 224 * 128; i += G * 512) *(v4u*)(WinT + (size_t)4640 * 1024 + (size_t)i * 8) = (v4u){0u, 0u, 0u, 0u};
            for (int i = gt; i < 64 * 32; i += G * 512) { const int pos = i >> 5, f = i & 31;
                const float invf = exp2f(-(float)f * (13.287712379549449f / 32.0f)); const float ang = (float)pos * invf;
                float sn, cs; sincosf(ang, &sn, &cs); ROPE[2 * i] = cs; ROPE[2 * i + 1] = sn; }
        }
    }
    SEAM(0);
    if (IN(1)) { PH_LOCALS;
        for (int m = gw; m < M_ALL; m += NGW) {
            const float* xr = m < M_LAT ? x + (size_t)m * 1024 : args.in[I_CTX] + (size_t)(m - M_LAT) * 1024;
            const int r = m < M_LAT ? (m >> 11) : 8;
            norm_mod_row_bf16(xr, MOD + r * 6144, MOD + r * 6144 + 1024, XN + (size_t)m * 1024, lane);
        }
    }
    SEAM(1);
    if (IN(2)) { PH_LOCALS;
        pg8::Gemm g{XN, WinT, 1024, 1024, 1024}; P2Order S; S.init(G, bx);
        EpiRow8<InProjF> E{InProjF{KB, VB, QKV, HALO, A2, DBDA}};
        pg8::gemm_phase<EpiRow8<InProjF>, P2Order, true, true>(lds, g, S, E);
    }
    SEAM(2);
    if (IN(3)) { PH_LOCALS;
        const float* knw = args.in[I_KNW];
        for (int kr = gw; kr < NB * KVLEN; kr += NGW) {
            const int b = kr / KVLEN, s = kr - b * KVLEN; const int head = lane >> 5, li = lane & 31;
            bf16* p = KB + (size_t)kr * 256 + head * 128 + 4 * li;
            const v2u raw = *(const v2u*)p; float v[4] = {bflo(raw.x), bfhi(raw.x), bflo(raw.y), bfhi(raw.y)};
            float ss = v[0] * v[0] + v[1] * v[1] + v[2] * v[2] + v[3] * v[3];
            ss += __shfl_xor(ss, 1); ss += __shfl_xor(ss, 2); ss += __shfl_xor(ss, 4); ss += __shfl_xor(ss, 8); ss += __shfl_xor(ss, 16);
            const float rstd = 1.0f / sqrtf(ss * (1.0f / 128.0f) + NORM_EPS); const f32x4 wv = *(const f32x4*)(knw + 4 * li);
#pragma unroll
            for (int e = 0; e < 4; ++e) v[e] *= rstd * wv[e];
            float pv[4];
#pragma unroll
            for (int e = 0; e < 4; ++e) pv[e] = __shfl_xor(v[e], 8);
            if (s >= CTXL) { const int t = s - CTXL, ax = li >> 4, pos = ax ? (t & 63) : (t >> 6); const bool x2 = (li & 8) != 0;
                const float* tb = ROPE + pos * 64 + 8 * (li & 7); const f32x4 c0 = *(const f32x4*)tb, c1 = *(const f32x4*)(tb + 4);
                const float cs[4] = {c0.x, c0.z, c1.x, c1.z}, sn[4] = {c0.y, c0.w, c1.y, c1.w};
#pragma unroll
                for (int e = 0; e < 4; ++e) v[e] = x2 ? v[e] * cs[e] + pv[e] * sn[e] : v[e] * cs[e] - pv[e] * sn[e]; }
            *(v2u*)p = (v2u){pk2(v[0], v[1]), pk2(v[2], v[3])};
        }
        gdn::PrepCtx PC{QKV, HALO, DBDA, args.in[I_CONVW], args.in[I_ALOG], args.in[I_DTB], TP, VEC};
        for (int u = vcu; u < NB * 8 * 9; u += G) { const int b = u / 72, rem = u - b * 72, h = rem / 9, g = rem - h * 9; gdn::prep_unit(PC, lds, b, h, g); }
    }
    SEAM(3);
    if (IN(4)) { PH_LOCALS;
#ifndef NO_SCAN
        if (bx < 128) {
            const int b = bx >> 4, h = (bx >> 1) & 7, dir = bx & 1;
            gdn::ScanCtx SC{QKV, TP, VEC, A2 + 1024, O1};
            for (int i = tid; i < 2 * 8192 / 16; i += 512) { const int bufi = i >> 9, o = i & 511; *(LAS v4u*)(lds + bufi * gdn::SB_STRIDE + gdn::SB_P + o * 16) = (v4u){0u, 0u, 0u, 0u}; }
            __syncthreads();
            if (wave >= 4) {
                gdn::scan_fill(SC, lds, b, h, dir, gdn::scan_cidx(dir, 0), 0);
                LDS_WAIT(); __syncthreads();
#pragma unroll 1
                for (int n = 0; n < NCH; ++n) { if (n + 1 < NCH) gdn::scan_fill(SC, lds, b, h, dir, gdn::scan_cidx(dir, n + 1), (n + 1) & 1); LDS_WAIT(); __syncthreads(); }
            } else {
                f32x16 Sacc[4]; v4u SBp[4][2];
#pragma unroll
                for (int t = 0; t < 4; ++t) { Sacc[t] = f32x16{}; SBp[t][0] = (v4u){0u, 0u, 0u, 0u}; SBp[t][1] = (v4u){0u, 0u, 0u, 0u}; }
                __syncthreads();
#pragma unroll 1
                for (int n = 0; n < NCH; ++n) { gdn::scan_step(SC, lds, b, h, dir, gdn::scan_cidx(dir, n), n & 1, Sacc, SBp); LDS_WAIT(); __syncthreads(); }
            }
            VM_WAIT();
        }
#endif
        __syncthreads();
#ifndef NO_ATTN
        for (;;) {
            if (tid == 0) MISC[16] = atomicAdd((unsigned*)(ctl + CW_QUEUE), 1u);
            __syncthreads(); const unsigned u = MISC[16]; __syncthreads();
            if (u >= 512u) break;
            const int b = u >> 6, rem = u & 63, kvh = rem >> 5, hq = (rem >> 3) & 3, h = kvh * 4 + hq, qb = rem & 7;
            att::attn_unit(A2 + ((size_t)b * SEQ + qb * 256) * 2048 + h * 128, KB + (size_t)b * KVLEN * 256 + kvh * 128, VB + (size_t)b * KVLEN * 256 + kvh * 128,
                           qb * 256, args.in[I_QNW], ROPE, KVLEN, (char*)lds_raw);
        }
#endif
    }
    SEAM(4);
    if (IN(5)) { PH_LOCALS;
        pg8::Gemm g{XN, WinT + (size_t)WIN_G_ROW0 * 1024, 1024, 1024, 1024}; pg8::StaticOrder S; S.init(64, 12, G, bx);
        EpiRow8<GateF> E{GateF{ZS, GATES}};
        pg8::gemm_phase<EpiRow8<GateF>, pg8::StaticOrder, true, true>(lds, g, S, E);
    }
    SEAM(5);
    if (IN(6)) { PH_LOCALS;
        const float* gnw = args.in[I_GNW];
        for (int m = gw; m < M_LAT; m += NGW) {
            bf16* p0 = A2 + (size_t)m * 2048 + 1024 + lane * 16; const bf16* p1 = O1 + (size_t)m * 1024 + lane * 16; const bf16* pz = ZS + (size_t)m * 1024 + lane * 16;
            float s[16]; float ss = 0.f;
#pragma unroll
            for (int q = 0; q < 2; ++q) { f32x4 a0, a1, b0, b1; unpack8(*(const v4u*)(p0 + 8 * q), a0, a1); unpack8(*(const v4u*)(p1 + 8 * q), b0, b1);
#pragma unroll
                for (int e = 0; e < 4; ++e) {
#ifdef ZERO_O1
                    b0[e] = 0.f; b1[e] = 0.f;
#endif
#ifdef ZERO_O0
                    a0[e] = 0.f; a1[e] = 0.f;
#endif
                    s[8 * q + e] = a0[e] + b0[e]; s[8 * q + 4 + e] = a1[e] + b1[e]; } }
#pragma unroll
            for (int e = 0; e < 16; ++e) ss += s[e] * s[e];
            ss += __shfl_xor(ss, 1); ss += __shfl_xor(ss, 2); ss += __shfl_xor(ss, 4);
            const float rstd = 1.0f / sqrtf(ss * (1.0f / 128.0f) + NORM_EPS);
#pragma unroll
            for (int q = 0; q < 2; ++q) { f32x4 z0, z1; unpack8(*(const v4u*)(pz + 8 * q), z0, z1); const float* gp = gnw + (lane & 7) * 16 + 8 * q; const f32x4 g0 = *(const f32x4*)gp, g1 = *(const f32x4*)(gp + 4);
                f32x4 r0, r1;
#pragma unroll
                for (int e = 0; e < 4; ++e) { r0[e] = s[8 * q + e] * rstd * g0[e] * z0[e]; r1[e] = s[8 * q + 4 + e] * rstd * g1[e] * z1[e]; }
                *(v4u*)(p0 + 8 * q) = pack8(r0, r1); }
        }
        __syncthreads();
        LAS float* scr = (LAS float*)(lds + wave * 16384);
        constexpr int I_PA = 16 * 32, I_UP = 16 * 176, I_DN = 44 * 32, NIT = 3 * I_PA + I_UP + I_DN;
        for (int it = gw; it < NIT; it += NGW) { int r = it;
            if (r < I_PA) { transpose_item(args.in[I_WPA], 1024, WmT, 2048, 0, (r & 31) * 32, scr, r >> 5, r & 31, lane); continue; } r -= I_PA;
            if (r < I_PA) { transpose_item(args.in[I_WPD], 1024, WmT, 2048, 1024, (r & 31) * 32, scr, r >> 5, r & 31, lane); continue; } r -= I_PA;
            if (r < I_PA) { transpose_item(args.in[I_WOUT], 1024, WoT, 1024, 0, (r & 31) * 32, scr, r >> 5, r & 31, lane); continue; } r -= I_PA;
            if (r < I_UP) { const int kb = r / 176, nb = r - kb * 176; const int n0 = nb * 32; const bool isv = n0 >= 2816; const int c = isv ? n0 - 2816 : n0;
                const int drow = (c >> 7) * 256 + (isv ? 128 : 0) + (c & 127);
                transpose_item(args.in[I_WUP], 5632, WupT, 1024, 0, drow, scr, kb, nb, lane); continue; } r -= I_UP;
            transpose_item(args.in[I_WDN], 1024, WdT, 2816, 0, (r & 31) * 32, scr, r >> 5, r & 31, lane);
        }
    }
    SEAM(6);
    if (IN(7)) { PH_LOCALS;
        pg8::Gemm g{A2, WmT, 1024, 2048, 2048}; pg8::StaticOrder S; S.init(64, 4, G, bx);
        EpiRow8<Merge1F> E{Merge1F{GATES, Y1}};
        pg8::gemm_phase<EpiRow8<Merge1F>, pg8::StaticOrder, true, true>(lds, g, S, E);
    }
    SEAM(7);
    if (IN(8)) { PH_LOCALS;
        pg8::Gemm g{A2 + 1024, WmT + 1024, 1024, 2048, 2048}; pg8::StaticOrder S; S.init(64, 4, G, bx);
        EpiRow8<Merge2F> E{Merge2F{GATES, Y1, Y}};
        pg8::gemm_phase<EpiRow8<Merge2F>, pg8::StaticOrder, true, true>(lds, g, S, E);
    }
    SEAM(8);
    if (IN(9)) { PH_LOCALS;
        pg8::Gemm g{Y, WoT, 1024, 1024, 1024}; pg8::StaticOrder S; S.init(64, 4, G, bx);
        EpiRow8<ResidF> E{ResidF{x, MOD, 2048, X1}};
        pg8::gemm_phase<EpiRow8<ResidF>, pg8::StaticOrder, true, true>(lds, g, S, E);
    }
    SEAM(9);
    if (IN(10)) { PH_LOCALS;
        for (int m = gw; m < M_LAT; m += NGW) { const int r = m >> 11; norm_mod_row_bf16(X1 + (size_t)m * 1024, MOD + r * 6144 + 3072, MOD + r * 6144 + 4096, H2 + (size_t)m * 1024, lane); }
    }
    SEAM(10);
    if (IN(11)) { PH_LOCALS;
        pg8::Gemm g{H2, WupT, 1024, 1024, 1024}; pg8::StaticOrder S; S.init(64, 22, G, bx);
        EpiFfnUp E{ACT, SIDE, args.in[I_FCW], args.in[I_FCB], (LAS float*)(lds + LDSX_OFF)};
        pg8::gemm_phase<EpiFfnUp, pg8::StaticOrder, true, true>(lds, g, S, E);
    }
    SEAM(11);
    if (IN(12)) { PH_LOCALS;
        pg8::StaticOrder S; S.init(64, 4, G, bx);
        { pg8::Unit uu; for (int i = 0; S.next(i, uu); ++i) ffn_fixup(ACT, SIDE, args.in[I_FCW], args.in[I_FCB], uu.pm, tid); }
        VM_WAIT(); __syncthreads();
        pg8::Gemm g{ACT, WdT, 2816, 2816, 2816};
        EpiRow8<ResidF> E{ResidF{X1, MOD, 5120, X1}};
        pg8::gemm_phase<EpiRow8<ResidF>, pg8::StaticOrder, true, true>(lds, g, S, E);
    }
    SEAM(12);
    if (IN(13)) { PH_LOCALS;
        const float* fw = args.in[I_FNW];
        for (int m = gw; m < M_LAT; m += NGW) { f32x4 v[4]; float rstd; float* row = X1 + (size_t)m * 1024; rms_row(row, lane, v, rstd);
#pragma unroll
            for (int j = 0; j < 4; ++j) { const f32x4 w = ((const f32x4*)fw)[lane + 64 * j]; ((f32x4*)row)[lane + 64 * j] = v[j] * rstd * w; } }
    }
#undef IN
#undef SEAM
}

constexpr int N_PHASES = 14;
extern "C" void kernel_launch(void* const* d_in, const int* in_sizes, int n_in, void* d_out, int out_size, void* d_ws, size_t ws_size, hipStream_t stream) {
    static int grid = 0;
    if (grid == 0) {
        if (n_in != N_IN || in_sizes[0] != M_LAT * DM || out_size != M_LAT * DM || ws_size < WS_END) {
            fprintf(stderr, "kernel_launch: unexpected shapes: n_in %d in0 %d out %d ws %zu\n", n_in, n_in > 0 ? in_sizes[0] : -1, out_size, ws_size); grid = -1; return; }
        int dev = 0, cus = 0, per_cu = 0;
        if (hipGetDevice(&dev) != hipSuccess || hipDeviceGetAttribute(&cus, hipDeviceAttributeMultiprocessorCount, dev) != hipSuccess) { grid = -1; return; }
        if (hipFuncSetAttribute((const void*)fwd_kernel, hipFuncAttributeMaxDynamicSharedMemorySize, LDS_BYTES) != hipSuccess) { fprintf(stderr, "kernel_launch: hipFuncSetAttribute failed\n"); grid = -1; return; }
        if (hipOccupancyMaxActiveBlocksPerMultiprocessor(&per_cu, (const void*)fwd_kernel, NWAVES * 64, LDS_BYTES) != hipSuccess || per_cu < 1) { fprintf(stderr, "kernel_launch: occupancy query says %d blocks per CU\n", per_cu); (void)hipGetLastError(); grid = -1; return; }
        grid = cus;
        if (grid != 256) fprintf(stderr, "kernel_launch: note: %d CUs\n", grid);
    }
    if (grid < 0) return;
    if (hipMemsetAsync((char*)d_ws + WS_CTL, 0, CTL_ZERO_BYTES, stream) != hipSuccess) { fprintf(stderr, "kernel_launch: memset failed\n"); return; }
#ifdef EXP_POISON
    (void)hipMemsetAsync((char*)d_ws + CTL_ZERO_BYTES, 0xAA, WS_END - CTL_ZERO_BYTES, stream); (void)hipMemsetAsync(d_out, 0xAA, (size_t)out_size * 4, stream);
#endif
    Args a{};
    for (int i = 0; i < N_IN; ++i) a.in[i] = (const float*)d_in[i];
    a.out = (float*)d_out; a.ws = (unsigned char*)d_ws; a.ph_lo = 0; a.ph_hi = N_PHASES;
    void* kargs[] = {&a};
    hipError_t e = hipLaunchCooperativeKernel((const void*)fwd_kernel, dim3(grid), dim3(NWAVES * 64), kargs, LDS_BYTES, stream);
    if (e != hipSuccess) fprintf(stderr, "kernel_launch: launch failed: %s\n", hipGetErrorName(e));
}
```
